# Optimizing an MI355X kernel written in HIP

```python
import math
import jax, jax.numpy as jnp
from jax import lax
import numpy as np

D_MODEL = 1024
BATCH = 8
SEQ = 4096
DEPTH = 1

N_META = 16
ATTN_HEADS = 4
HEAD_DIM = 64
V_DIM = 2 * HEAD_DIM
ATTN_WIDTH = ATTN_HEADS * V_DIM
CONV_WIDTH = 512
CONV_GROUPS = 8
CONV_K = 3
N_BRANCH = 2
N_BUCKETS = 32
MAX_DISTANCE = 128
Q_BLOCK = 128
EPS = 1e-6
NEG_INF = -1e30

SPLIT_SIZES = (
    ATTN_HEADS * 2 * HEAD_DIM,
    ATTN_HEADS * 2 * HEAD_DIM,
    ATTN_WIDTH,
    ATTN_WIDTH,
    CONV_WIDTH,
    CONV_WIDTH,
    CONV_WIDTH,
    CONV_WIDTH,
    N_BRANCH * D_MODEL,
)
IN_COLS = int(sum(SPLIT_SIZES))

kernel_name = "hybrid_diffattn_shortconv_gated_merge"


def rms_norm(x, g):
    xf = x.astype(jnp.float32)
    r = xf * lax.rsqrt(jnp.mean(xf * xf, axis=-1, keepdims=True) + EPS)
    return (r * g.astype(jnp.float32)).astype(x.dtype)


def rel_bucket(n):
    max_exact = N_BUCKETS // 2
    nf = jnp.maximum(n, max_exact).astype(jnp.float32)
    large = max_exact + (jnp.log(nf / max_exact) / math.log(MAX_DISTANCE / max_exact)
                         * (N_BUCKETS - max_exact)).astype(jnp.int32)
    large = jnp.minimum(large, N_BUCKETS - 1)
    return jnp.where(n < max_exact, n, large)


def diff_attention(q, k, v, rel_bias, lam):
    B, L, H, _, Dh = q.shape
    nblk = L // Q_BLOCK
    scale = Dh ** -0.5
    qt = jnp.transpose(q.astype(jnp.float32), (0, 2, 3, 1, 4))
    kt = jnp.transpose(k.astype(jnp.float32), (0, 2, 3, 1, 4))
    vt = jnp.transpose(v.astype(jnp.float32), (0, 2, 1, 3))
    qb = qt.reshape(B, H, 2, nblk, Q_BLOCK, Dh)
    qb = jnp.moveaxis(qb, 3, 0)
    offsets = jnp.arange(nblk, dtype=jnp.int32) * Q_BLOCK
    kpos = jnp.arange(L, dtype=jnp.int32)
    bias_tab = rel_bias.astype(jnp.float32)

    def block(args):
        q_blk, q0 = args
        s = jnp.einsum('bhcqd,bhckd->bhcqk', q_blk, kt) * scale
        qpos = q0 + jnp.arange(Q_BLOCK, dtype=jnp.int32)
        dist = qpos[:, None] - kpos[None, :]
        bias = bias_tab[rel_bucket(jnp.maximum(dist, 0))]
        s = s + jnp.transpose(bias, (2, 3, 0, 1))[None]
        s = jnp.where((dist >= 0)[None, None, None], s, NEG_INF)
        p = jax.nn.softmax(s, axis=-1)
        a = p[:, :, 0] - lam * p[:, :, 1]
        return jnp.einsum('bhqk,bhkv->bhqv', a, vt)

    out = lax.map(block, (qb, offsets))
    out = jnp.transpose(out, (1, 0, 3, 2, 4)).reshape(B, L, H, -1)
    return out.astype(v.dtype)


def short_conv(u, w):
    L = u.shape[1]
    up = jnp.pad(u, ((0, 0), (CONV_K - 1, 0), (0, 0)))
    y = w[0] * up[:, 0:L]
    for j in range(1, CONV_K):
        y = y + w[j] * up[:, j:j + L]
    return y


def setup_inputs(seed: int = 0) -> dict:
    key = jax.random.key(seed)
    ks = jax.random.split(key, 16)
    f32 = jnp.float32
    x = jax.random.normal(ks[0], (BATCH, SEQ, D_MODEL), f32)
    meta_tokens = jax.random.normal(ks[1], (N_META, D_MODEL), f32)
    rel_bias = 0.5 * jax.random.normal(ks[2], (N_BUCKETS, ATTN_HEADS, 2), f32)
    norm_g = 1.0 + 0.02 * jax.random.normal(ks[3], (DEPTH, D_MODEL), f32)
    w_in = jax.random.normal(ks[4], (DEPTH, D_MODEL, IN_COLS), f32) * D_MODEL ** -0.5
    q_norm_g = 1.0 + 0.02 * jax.random.normal(ks[5], (DEPTH, HEAD_DIM), f32)
    k_norm_g = 1.0 + 0.02 * jax.random.normal(ks[6], (DEPTH, HEAD_DIM), f32)
    lambda_q1 = 0.1 * jax.random.normal(ks[7], (DEPTH, HEAD_DIM), f32)
    lambda_k1 = 0.1 * jax.random.normal(ks[8], (DEPTH, HEAD_DIM), f32)
    lambda_q2 = 0.1 * jax.random.normal(ks[9], (DEPTH, HEAD_DIM), f32)
    lambda_k2 = 0.1 * jax.random.normal(ks[10], (DEPTH, HEAD_DIM), f32)
    subln_g = 1.0 + 0.02 * jax.random.normal(ks[11], (DEPTH, V_DIM), f32)
    conv_w = jax.random.normal(ks[12], (DEPTH, CONV_K, CONV_WIDTH), f32) * CONV_K ** -0.5
    w_branch = jax.random.normal(ks[13], (DEPTH, N_BRANCH, ATTN_WIDTH, D_MODEL), f32) * ATTN_WIDTH ** -0.5
    w_out = jax.random.normal(ks[14], (DEPTH, D_MODEL, D_MODEL), f32) * D_MODEL ** -0.5
    return {"x": x, "meta_tokens": meta_tokens, "rel_bias": rel_bias, "norm_g": norm_g,
            "w_in": w_in, "q_norm_g": q_norm_g, "k_norm_g": k_norm_g,
            "lambda_q1": lambda_q1, "lambda_k1": lambda_k1, "lambda_q2": lambda_q2,
            "lambda_k2": lambda_k2, "subln_g": subln_g, "conv_w": conv_w,
            "w_branch": w_branch, "w_out": w_out}


def reference(x, meta_tokens, rel_bias, norm_g, w_in, q_norm_g, k_norm_g,
              lambda_q1, lambda_k1, lambda_q2, lambda_k2, subln_g, conv_w,
              w_branch, w_out):
    B, S, D = x.shape
    L = N_META + S
    Lp = ((L + Q_BLOCK - 1) // Q_BLOCK) * Q_BLOCK
    meta = jnp.broadcast_to(meta_tokens.astype(x.dtype)[None], (B, N_META, D))
    h = jnp.concatenate([meta, x], axis=1)
    h = jnp.pad(h, ((0, 0), (0, Lp - L), (0, 0)))
    split_idx = [int(i) for i in np.cumsum(SPLIT_SIZES)[:-1]]

    for layer in range(DEPTH):
        lam_init = 0.8 - 0.6 * math.exp(-0.3 * layer)
        xn = rms_norm(h, norm_g[layer])
        proj = jnp.einsum('bld,dc->blc', xn, w_in[layer])
        q, k, v, g_attn, c_b, c_c, c_h, g_conv, g_merge = jnp.split(proj, split_idx, axis=-1)

        q = rms_norm(q.reshape(B, Lp, ATTN_HEADS, 2, HEAD_DIM), q_norm_g[layer])
        k = rms_norm(k.reshape(B, Lp, ATTN_HEADS, 2, HEAD_DIM), k_norm_g[layer])
        v = v.reshape(B, Lp, ATTN_HEADS, V_DIM)
        lam = (jnp.exp(jnp.sum(lambda_q1[layer].astype(jnp.float32) * lambda_k1[layer].astype(jnp.float32)))
               - jnp.exp(jnp.sum(lambda_q2[layer].astype(jnp.float32) * lambda_k2[layer].astype(jnp.float32)))
               + lam_init)
        a = diff_attention(q, k, v, rel_bias, lam)
        a = rms_norm(a, subln_g[layer]) * (1.0 - lam_init)
        a = a.reshape(B, Lp, ATTN_WIDTH) * jax.nn.silu(g_attn)

        c = c_b * short_conv(c_c * c_h, conv_w[layer].astype(h.dtype))
        c = c * jax.nn.silu(g_conv)

        br = jnp.stack([a, c], axis=2)
        y = jnp.einsum('blnc,ncd->blnd', br, w_branch[layer])
        gate = jax.nn.sigmoid(g_merge.reshape(B, Lp, N_BRANCH, D))
        merged = jnp.sum(gate * y, axis=2)
        h = h + jnp.einsum('bld,de->ble', merged, w_out[layer])

    return h[:, N_META:N_META + S]
```

```cpp
#include <hip/hip_runtime.h>
#include <cstdio>
#include <cstdint>

constexpr int BATCH = 8, SEQ = 4096, DM = 1024, NMETA = 16, LTOK = NMETA + SEQ  , MROWS = BATCH * SEQ  ;
constexpr int NH = 4, HD = 64, VD = 128, AW = 512, CW = 512, INC = 6144;
constexpr int NKT = 66;
constexpr float EPS = 1e-6f;
constexpr float LOG2E = 1.4426950408889634f;
constexpr float C2 = 0.125f * LOG2E;
constexpr float LAM_INIT = 0.2f;

typedef unsigned short bf16_t;
__device__ __forceinline__ unsigned f2bf(float f) { unsigned u = __builtin_bit_cast(unsigned, f); return (u + 0x7fffu + ((u >> 16) & 1u)) >> 16; }
__device__ __forceinline__ float bf2f(unsigned short h) { return __builtin_bit_cast(float, (unsigned)h << 16); }

constexpr size_t MiB = 1u << 20;
constexpr size_t WS_CTL = 0;
constexpr size_t WS_RS = 1 * MiB;
constexpr size_t WS_WIN = 2 * MiB;
constexpr size_t WS_WBR = 14 * MiB;
constexpr size_t WS_WOUT = 16 * MiB;
constexpr size_t WS_XB = 18 * MiB;
constexpr size_t WS_BR = WS_XB;
constexpr size_t WS_Q = 82 * MiB;
constexpr size_t WS_K = 114 * MiB;
constexpr size_t WS_MERGED = WS_Q;
constexpr size_t WS_V = 147 * MiB;
constexpr size_t WS_SG = 180 * MiB;
constexpr size_t WS_U = 212 * MiB;
constexpr size_t WS_GB = 245 * MiB;
constexpr size_t WS_GATE = 277 * MiB;
constexpr size_t WS_END = 405 * MiB;

__host__ __device__ __forceinline__ size_t kimg_off(int b, int h, int c, int pos, int d) {
    const int j = pos >> 6, row = pos & 63, chunk = d >> 3;
    const size_t tile = (size_t)((b * NH + h) * 2 + c) * NKT + j;
    return tile * 4096 + row * 64 + ((chunk ^ ((row >> 1) & 7)) << 3) + (d & 7);
}
__host__ __device__ __forceinline__ size_t vimg_off(int b, int h, int pos, int dv) {
    const int j = pos >> 6, k = pos & 63;
    const int kk = (k & ~0xC) | ((k & 4) << 1) | ((k & 8) >> 1);
    const size_t tile = (size_t)(b * NH + h) * NKT + j;
    return tile * 8192 + ((kk >> 3) * 4 + (dv >> 5)) * 256 + (kk & 7) * 32 + (dv & 31);
}
__device__ __forceinline__ int t5_bucket(int d) {
    if (d < 16) return d;
    int b = 16;
    b += (d >= 19); b += (d >= 21); b += (d >= 24); b += (d >= 27); b += (d >= 31); b += (d >= 35); b += (d >= 40); b += (d >= 46);
    b += (d >= 52); b += (d >= 59); b += (d >= 67); b += (d >= 77); b += (d >= 87); b += (d >= 99); b += (d >= 113);
    return b;
}
__device__ __forceinline__ float wave_sum(float v) {
#pragma unroll
    for (int o = 1; o < 64; o <<= 1) v += __shfl_xor(v, o);
    return v;
}
__device__ __forceinline__ float wave_max(float v) {
#pragma unroll
    for (int o = 1; o < 64; o <<= 1) v = fmaxf(v, __shfl_xor(v, o));
    return v;
}
__device__ __forceinline__ float silu_f(float v) { return v / (1.f + __expf(-v)); }
__device__ __forceinline__ float sigmoid_f(float v) { return 1.f / (1.f + __expf(-v)); }

struct Ptrs {
    const float *x, *meta, *rel_bias, *norm_g, *w_in, *q_norm_g, *k_norm_g, *lq1, *lk1, *lq2, *lk2, *subln_g, *conv_w, *w_branch, *w_out;
    float* out; unsigned char* ws;
};

__global__ void __launch_bounds__(256) ref_rowscale(Ptrs P) {
    const int wave = (blockIdx.x * 256 + threadIdx.x) >> 6, lane = threadIdx.x & 63;
    if (wave >= BATCH * LTOK) return;
    const int b = wave / LTOK, l = wave % LTOK;
    const float* hr = l < NMETA ? P.meta + (size_t)l * DM : P.x + ((size_t)b * SEQ + (l - NMETA)) * DM;
    float s = 0.f;
    for (int i = lane; i < DM; i += 64) { const float v = hr[i]; s += v * v; }
    s = wave_sum(s);
    if (lane == 0) ((float*)(P.ws + WS_RS))[wave] = rsqrtf(s * (1.f / DM) + EPS);
}

template <class FA, class FB>
__device__ __forceinline__ void sgemm_tile(float (&acc)[4][4], int K, FA fa, FB fb, float* As, float* Bs) {
    const int tid = threadIdx.x, ty = tid >> 4, tx = tid & 15;
#pragma unroll
    for (int i = 0; i < 4; ++i)
#pragma unroll
        for (int j = 0; j < 4; ++j) acc[i][j] = 0.f;
    for (int k0 = 0; k0 < K; k0 += 16) {
#pragma unroll
        for (int i = 0; i < 4; ++i) { const int idx = tid + i * 256; const int row = idx >> 4, kk = idx & 15; As[kk * 64 + row] = fa(row, k0 + kk); }
#pragma unroll
        for (int i = 0; i < 4; ++i) { const int idx = tid + i * 256; const int kk = idx >> 6, col = idx & 63; Bs[kk * 64 + col] = fb(k0 + kk, col); }
        __syncthreads();
#pragma unroll
        for (int kk = 0; kk < 16; ++kk) {
            float a[4], bv[4];
#pragma unroll
            for (int i = 0; i < 4; ++i) a[i] = As[kk * 64 + ty * 4 + i];
#pragma unroll
            for (int j = 0; j < 4; ++j) bv[j] = Bs[kk * 64 + tx * 4 + j];
#pragma unroll
            for (int i = 0; i < 4; ++i)
#pragma unroll
                for (int j = 0; j < 4; ++j) acc[i][j] += a[i] * bv[j];
        }
        __syncthreads();
    }
}

__global__ void __launch_bounds__(256) ref_proj(Ptrs P) {
    __shared__ float As[16 * 64], Bs[16 * 64], T0[64 * 65], T1[64 * 65];
    const int task = blockIdx.y, rt = blockIdx.x, b = rt / 65, l0 = (rt % 65) * 64;
    const int tid = threadIdx.x, ty = tid >> 4, tx = tid & 15;
    const float* RS = (const float*)(P.ws + WS_RS);
    bf16_t* Qb = (bf16_t*)(P.ws + WS_Q); bf16_t* Kb = (bf16_t*)(P.ws + WS_K); bf16_t* Vb = (bf16_t*)(P.ws + WS_V);
    bf16_t* SGb = (bf16_t*)(P.ws + WS_SG); bf16_t* Ub = (bf16_t*)(P.ws + WS_U); bf16_t* GBb = (bf16_t*)(P.ws + WS_GB); bf16_t* GTb = (bf16_t*)(P.ws + WS_GATE);
    auto fa = [&](int row, int k) -> float {
        const int l = l0 + row; if (l >= LTOK) return 0.f;
        const float* hr = l < NMETA ? P.meta + (size_t)l * DM : P.x + ((size_t)b * SEQ + (l - NMETA)) * DM;
        return hr[k] * P.norm_g[k];
    };
    float acc[4][4];
    auto run = [&](int c0, float* T) {
        auto fb = [&](int k, int col) -> float { return P.w_in[(size_t)k * INC + c0 + col]; };
        sgemm_tile(acc, DM, fa, fb, As, Bs);
#pragma unroll
        for (int i = 0; i < 4; ++i) { const int row = ty * 4 + i; const int l = l0 + row; const float rs = l < LTOK ? RS[b * LTOK + l] : 0.f;
#pragma unroll
            for (int j = 0; j < 4; ++j) T[row * 65 + tx * 4 + j] = acc[i][j] * rs; }
        __syncthreads();
    };
    int type, g;
    if (task < 8) { type = 0; g = task; } else if (task < 16) { type = 1; g = task - 8; } else if (task < 24) { type = 2; g = task - 16; }
    else if (task < 32) { type = 3; g = task - 24; } else if (task < 40) { type = 4; g = task - 32; } else { type = 5; g = task - 40; }
    if (type == 4) {
        run(2048 + 512 + 64 * g, T0); run(2048 + 1024 + 64 * g, T1);
        for (int e = tid; e < 4096; e += 256) { const int row = e >> 6, col = e & 63, l = l0 + row; if (l >= LTOK) continue;
            Ub[((size_t)b * LTOK + l) * CW + 64 * g + col] = (bf16_t)f2bf(T0[row * 65 + col] * T1[row * 65 + col]); }
        __syncthreads();
        run(2048 + 64 * g, T0); run(2048 + 1536 + 64 * g, T1);
        for (int e = tid; e < 4096; e += 256) { const int row = e >> 6, col = e & 63, l = l0 + row; if (l >= LTOK || l < NMETA) continue;
            const size_t m = (size_t)b * SEQ + (l - NMETA);
            GBb[m * CW + 64 * g + col] = (bf16_t)f2bf(T0[row * 65 + col] * silu_f(T1[row * 65 + col])); }
        return;
    }
    const int c0 = type == 0 ? 64 * g : type == 1 ? 512 + 64 * g : type == 2 ? 1024 + 64 * g : type == 3 ? 1536 + 64 * g : 4096 + 64 * g;
    run(c0, T0);
    for (int e = tid; e < 4096; e += 256) {
        const int row = e >> 6, col = e & 63, l = l0 + row; if (l >= LTOK) continue;
        const float v = T0[row * 65 + col];
        const size_t m = (size_t)b * SEQ + (l - NMETA);
        if (type <= 1) {
            float ss = 0.f;
            for (int j = 0; j < 64; ++j) { const float t = T0[row * 65 + j]; ss += t * t; }
            const float nv = v * rsqrtf(ss * (1.f / 64.f) + EPS);
            if (type == 0) { if (l >= NMETA) Qb[m * AW + 64 * g + col] = (bf16_t)f2bf(nv * P.q_norm_g[col] * C2); }
            else Kb[kimg_off(b, g >> 1, g & 1, l, col)] = (bf16_t)f2bf(nv * P.k_norm_g[col]);
        } else if (type == 2) {
            Vb[vimg_off(b, g >> 1, l, (g & 1) * 64 + col)] = (bf16_t)f2bf(v);
        } else if (type == 3) {
            if (l >= NMETA) SGb[m * AW + 64 * g + col] = (bf16_t)f2bf(silu_f(v));
        } else {
            if (l >= NMETA) GTb[m * 2048 + 64 * g + col] = (bf16_t)f2bf(sigmoid_f(v));
        }
    }
}

__global__ void __launch_bounds__(256) ref_conv(Ptrs P) {
    const size_t id = (size_t)blockIdx.x * 256 + threadIdx.x;
    const int m = (int)(id >> 6), ch0 = (int)(id & 63) * 8;
    if (m >= MROWS) return;
    const int b = m / SEQ, s = m % SEQ; const size_t ur = (size_t)b * LTOK + s + NMETA;
    const bf16_t* Ub = (const bf16_t*)(P.ws + WS_U); const bf16_t* GBb = (const bf16_t*)(P.ws + WS_GB); bf16_t* BR = (bf16_t*)(P.ws + WS_BR);
    for (int i = 0; i < 8; ++i) { const int ch = ch0 + i;
        const float y = P.conv_w[ch] * bf2f(Ub[(ur - 2) * CW + ch]) + P.conv_w[CW + ch] * bf2f(Ub[(ur - 1) * CW + ch]) + P.conv_w[2 * CW + ch] * bf2f(Ub[ur * CW + ch]);
        BR[(size_t)m * 1024 + 512 + ch] = (bf16_t)f2bf(bf2f(GBb[(size_t)m * CW + ch]) * y); }
}

__device__ __forceinline__ float compute_lam(const Ptrs& P, int lane) {
    const float a = wave_sum(P.lq1[lane] * P.lk1[lane]), c = wave_sum(P.lq2[lane] * P.lk2[lane]);
    return __expf(a) - __expf(c) + LAM_INIT;
}

__device__ __forceinline__ void ref_scores(const Ptrs& P, const bf16_t* Kb, const float* qsw, int b, int h, int pos, int key, float& s1, float& s2) {
    s1 = 0.f; s2 = 0.f;
#pragma unroll
    for (int ck = 0; ck < 8; ++ck) {
        const uint4 k1 = *(const uint4*)(Kb + kimg_off(b, h, 0, key, ck * 8)), k2 = *(const uint4*)(Kb + kimg_off(b, h, 1, key, ck * 8));
        const unsigned w1[4] = {k1.x, k1.y, k1.z, k1.w}, w2[4] = {k2.x, k2.y, k2.z, k2.w};
#pragma unroll
        for (int i = 0; i < 4; ++i) {
            s1 += qsw[ck * 8 + 2 * i] * __builtin_bit_cast(float, w1[i] << 16) + qsw[ck * 8 + 2 * i + 1] * __builtin_bit_cast(float, w1[i] & 0xffff0000u);
            s2 += qsw[64 + ck * 8 + 2 * i] * __builtin_bit_cast(float, w2[i] << 16) + qsw[64 + ck * 8 + 2 * i + 1] * __builtin_bit_cast(float, w2[i] & 0xffff0000u);
        }
    }
    const int bk = t5_bucket(pos - key);
    s1 += P.rel_bias[(bk * NH + h) * 2 + 0] * LOG2E; s2 += P.rel_bias[(bk * NH + h) * 2 + 1] * LOG2E;
}

__global__ void __launch_bounds__(256) ref_attn(Ptrs P) {
    __shared__ float qs[4][2][64], ps[4][2][64];
    const int w = threadIdx.x >> 6, lane = threadIdx.x & 63;
    const int gw = blockIdx.x * 4 + w; const int m = gw >> 2, h = gw & 3;
    const int b = m / SEQ, s = m % SEQ, pos = s + NMETA;
    const bf16_t* Qb = (const bf16_t*)(P.ws + WS_Q); const bf16_t* Kb = (const bf16_t*)(P.ws + WS_K); const bf16_t* Vb = (const bf16_t*)(P.ws + WS_V);
    const bf16_t* SGb = (const bf16_t*)(P.ws + WS_SG); bf16_t* BR = (bf16_t*)(P.ws + WS_BR);
    qs[w][0][lane] = bf2f(Qb[(size_t)m * AW + h * 128 + lane]); qs[w][1][lane] = bf2f(Qb[(size_t)m * AW + h * 128 + 64 + lane]);
    const float lam = compute_lam(P, lane);
    __syncthreads();
    const int nch = pos / 64 + 1;
    float m1 = -1e30f, m2 = -1e30f;
    for (int ch = 0; ch < nch; ++ch) {
        const int key = ch * 64 + lane; if (key > pos) continue;
        float s1, s2; ref_scores(P, Kb, &qs[w][0][0], b, h, pos, key, s1, s2);
        m1 = fmaxf(m1, s1); m2 = fmaxf(m2, s2);
    }
    m1 = wave_max(m1); m2 = wave_max(m2);
    float l1 = 0.f, l2 = 0.f, o1a = 0.f, o1b = 0.f, o2a = 0.f, o2b = 0.f;
    for (int ch = 0; ch < nch; ++ch) {
        const int key = ch * 64 + lane;
        float p1 = 0.f, p2 = 0.f;
        if (key <= pos) {
            float s1, s2; ref_scores(P, Kb, &qs[w][0][0], b, h, pos, key, s1, s2);
            p1 = exp2f(s1 - m1); p2 = exp2f(s2 - m2);
        }
        l1 += p1; l2 += p2;
        ps[w][0][lane] = p1; ps[w][1][lane] = p2;
        __builtin_amdgcn_s_waitcnt(0xC07F); __builtin_amdgcn_wave_barrier();
        const int kmax = (pos - ch * 64) < 63 ? (pos - ch * 64) : 63;
        for (int kk = 0; kk <= kmax; ++kk) {
            const int key2 = ch * 64 + kk;
            const float va = bf2f(Vb[vimg_off(b, h, key2, lane)]), vb = bf2f(Vb[vimg_off(b, h, key2, 64 + lane)]);
            const float q1 = ps[w][0][kk], q2 = ps[w][1][kk];
            o1a += q1 * va; o1b += q1 * vb; o2a += q2 * va; o2b += q2 * vb;
        }
        __builtin_amdgcn_s_waitcnt(0xC07F); __builtin_amdgcn_wave_barrier();
    }
    l1 = wave_sum(l1); l2 = wave_sum(l2);
    const float aa = o1a / l1 - lam * (o2a / l2), ab = o1b / l1 - lam * (o2b / l2);
    const float ss = wave_sum(aa * aa + ab * ab);
    const float rn = rsqrtf(ss * (1.f / 128.f) + EPS) * (1.f - LAM_INIT);
    const size_t sgo = (size_t)m * AW + h * 128;
    BR[(size_t)m * 1024 + h * 128 + lane] = (bf16_t)f2bf(aa * rn * P.subln_g[lane] * bf2f(SGb[sgo + lane]));
    BR[(size_t)m * 1024 + h * 128 + 64 + lane] = (bf16_t)f2bf(ab * rn * P.subln_g[64 + lane] * bf2f(SGb[sgo + 64 + lane]));
}

__global__ void __launch_bounds__(256) ref_merge(Ptrs P) {
    __shared__ float As[16 * 64], Bs[16 * 64];
    const int r0 = blockIdx.x * 64, n0 = blockIdx.y * 64, tid = threadIdx.x, ty = tid >> 4, tx = tid & 15;
    const bf16_t* BR = (const bf16_t*)(P.ws + WS_BR); const bf16_t* GTb = (const bf16_t*)(P.ws + WS_GATE); bf16_t* MG = (bf16_t*)(P.ws + WS_MERGED);
    float y0[4][4], y1[4][4];
    { auto fa = [&](int row, int k) -> float { return bf2f(BR[(size_t)(r0 + row) * 1024 + k]); };
      auto fb = [&](int k, int col) -> float { return P.w_branch[(size_t)k * DM + n0 + col]; };
      sgemm_tile(y0, 512, fa, fb, As, Bs); }
    { auto fa = [&](int row, int k) -> float { return bf2f(BR[(size_t)(r0 + row) * 1024 + 512 + k]); };
      auto fb = [&](int k, int col) -> float { return P.w_branch[(size_t)(512 + k) * DM + n0 + col]; };
      sgemm_tile(y1, 512, fa, fb, As, Bs); }
#pragma unroll
    for (int i = 0; i < 4; ++i)
#pragma unroll
        for (int j = 0; j < 4; ++j) { const size_t m = r0 + ty * 4 + i; const int n = n0 + tx * 4 + j;
            const float g0 = bf2f(GTb[m * 2048 + n]), g1 = bf2f(GTb[m * 2048 + 1024 + n]);
            MG[m * 1024 + n] = (bf16_t)f2bf(g0 * y0[i][j] + g1 * y1[i][j]); }
}

__global__ void __launch_bounds__(256) ref_out(Ptrs P) {
    __shared__ float As[16 * 64], Bs[16 * 64];
    const int r0 = blockIdx.x * 64, n0 = blockIdx.y * 64, tid = threadIdx.x, ty = tid >> 4, tx = tid & 15;
    const bf16_t* MG = (const bf16_t*)(P.ws + WS_MERGED);
    float acc[4][4];
    auto fa = [&](int row, int k) -> float { return bf2f(MG[(size_t)(r0 + row) * 1024 + k]); };
    auto fb = [&](int k, int col) -> float { return P.w_out[(size_t)k * DM + n0 + col]; };
    sgemm_tile(acc, DM, fa, fb, As, Bs);
#pragma unroll
    for (int i = 0; i < 4; ++i)
#pragma unroll
        for (int j = 0; j < 4; ++j) { const size_t m = r0 + ty * 4 + i; const int n = n0 + tx * 4 + j; P.out[m * DM + n] = P.x[m * DM + n] + acc[i][j]; }
}

extern "C" void kernel_launch(void* const* d_in, const int* in_sizes, int n_in, void* d_out, int out_size, void* d_ws, size_t ws_size, hipStream_t stream) {
    if (n_in != 15 || out_size != MROWS * DM || ws_size < WS_END) { fprintf(stderr, "kernel_launch: unexpected shapes n_in %d out %d ws %zu\n", n_in, out_size, ws_size); return; }
    Ptrs P{};
    P.x = (const float*)d_in[0]; P.meta = (const float*)d_in[1]; P.rel_bias = (const float*)d_in[2]; P.norm_g = (const float*)d_in[3]; P.w_in = (const float*)d_in[4];
    P.q_norm_g = (const float*)d_in[5]; P.k_norm_g = (const float*)d_in[6]; P.lq1 = (const float*)d_in[7]; P.lk1 = (const float*)d_in[8]; P.lq2 = (const float*)d_in[9];
    P.lk2 = (const float*)d_in[10]; P.subln_g = (const float*)d_in[11]; P.conv_w = (const float*)d_in[12]; P.w_branch = (const float*)d_in[13]; P.w_out = (const float*)d_in[14];
    P.out = (float*)d_out; P.ws = (unsigned char*)d_ws;
    hipLaunchKernelGGL(ref_rowscale, dim3((BATCH * LTOK * 64 + 255) / 256), dim3(256), 0, stream, P);
    hipLaunchKernelGGL(ref_proj, dim3(BATCH * 65, 72), dim3(256), 0, stream, P);
    hipLaunchKernelGGL(ref_conv, dim3(MROWS * 64 / 256), dim3(256), 0, stream, P);
    hipLaunchKernelGGL(ref_attn, dim3(MROWS * NH / 4), dim3(256), 0, stream, P);
    hipLaunchKernelGGL(ref_merge, dim3(MROWS / 64, DM / 64), dim3(256), 0, stream, P);
    hipLaunchKernelGGL(ref_out, dim3(MROWS / 64, DM / 64), dim3(256), 0, stream, P);
}
```

```cpp
#include <hip/hip_runtime.h>
#include <cstdio>
#include <cstdint>

constexpr int BATCH = 8, SEQ = 4096, DM = 1024, NMETA = 16, LTOK = NMETA + SEQ  , MROWS = BATCH * SEQ  ;
constexpr int NH = 4, HD = 64, VD = 128, AW = 512, CW = 512, INC = 6144;
constexpr int NKT = 66;
constexpr float EPS = 1e-6f;
constexpr float LOG2E = 1.4426950408889634f;
constexpr float C2 = 0.125f * LOG2E;
constexpr float LAM_INIT = 0.2f;

typedef unsigned short bf16_t;
__device__ __forceinline__ float bf2f(unsigned short h) { return __builtin_bit_cast(float, (unsigned)h << 16); }

constexpr size_t MiB = 1u << 20;
constexpr size_t WS_CTL = 0;
constexpr size_t WS_RS = 1 * MiB;
constexpr size_t WS_WIN = 2 * MiB;
constexpr size_t WS_WBR = 14 * MiB;
constexpr size_t WS_WOUT = 16 * MiB;
constexpr size_t WS_XB = 18 * MiB;
constexpr size_t WS_BR = 405 * MiB;
constexpr size_t WS_Q = 82 * MiB;
constexpr size_t WS_K = 114 * MiB;
constexpr size_t WS_MERGED = WS_Q;
constexpr size_t WS_V = 147 * MiB;
constexpr size_t WS_SG = 180 * MiB;
constexpr size_t WS_U = 212 * MiB;
constexpr size_t WS_GB = 245 * MiB;
constexpr size_t WS_GATE = 277 * MiB;
constexpr size_t WS_END = 469 * MiB;

__host__ __device__ __forceinline__ size_t kimg_off(int b, int h, int c, int pos, int d) {
    const int j = pos >> 6, row = pos & 63, chunk = d >> 3;
    const size_t tile = (size_t)((b * NH + h) * 2 + c) * NKT + j;
    return tile * 4096 + row * 64 + ((chunk ^ ((row >> 1) & 7)) << 3) + (d & 7);
}
__host__ __device__ __forceinline__ size_t vimg_off(int b, int h, int pos, int dv) {
    const int j = pos >> 6, k = pos & 63;
    const int kk = (k & ~0xC) | ((k & 4) << 1) | ((k & 8) >> 1);
    const size_t tile = (size_t)(b * NH + h) * NKT + j;
    return tile * 8192 + ((kk >> 3) * 4 + (dv >> 5)) * 256 + (kk & 7) * 32 + (dv & 31);
}
__device__ __forceinline__ int t5_bucket(int d) {
    if (d < 16) return d;
    int b = 16;
    b += (d >= 19); b += (d >= 21); b += (d >= 24); b += (d >= 27); b += (d >= 31); b += (d >= 35); b += (d >= 40); b += (d >= 46);
    b += (d >= 52); b += (d >= 59); b += (d >= 67); b += (d >= 77); b += (d >= 87); b += (d >= 99); b += (d >= 113);
    return b;
}
__device__ __forceinline__ float wave_sum(float v) {
#pragma unroll
    for (int o = 1; o < 64; o <<= 1) v += __shfl_xor(v, o);
    return v;
}
__device__ __forceinline__ float wave_max(float v) {
#pragma unroll
    for (int o = 1; o < 64; o <<= 1) v = fmaxf(v, __shfl_xor(v, o));
    return v;
}
__device__ __forceinline__ float silu_f(float v) { return v / (1.f + __expf(-v)); }
__device__ __forceinline__ float sigmoid_f(float v) { return 1.f / (1.f + __expf(-v)); }

struct Ptrs {
    const float *x, *meta, *rel_bias, *norm_g, *w_in, *q_norm_g, *k_norm_g, *lq1, *lk1, *lq2, *lk2, *subln_g, *conv_w, *w_branch, *w_out;
    float* out; unsigned char* ws;
};

#define GAS __attribute__((address_space(1)))
#define LAS __attribute__((address_space(3)))
typedef unsigned short bf16;
typedef unsigned v4u __attribute__((ext_vector_type(4)));
typedef float f32x4 __attribute__((ext_vector_type(4)));
typedef short bf16x8 __attribute__((ext_vector_type(8)));
typedef GAS unsigned gu32;
typedef GAS unsigned long long gu64;
#define RLX_AGENT __ATOMIC_RELAXED, __HIP_MEMORY_SCOPE_AGENT
#define LDS_WAIT() asm volatile("s_waitcnt lgkmcnt(0)" ::: "memory")
#define VM_WAIT() asm volatile("s_waitcnt vmcnt(0)" ::: "memory")
__device__ __forceinline__ unsigned long long rt() { return __builtin_amdgcn_s_memrealtime(); }
__device__ __forceinline__ unsigned f2bf(float f) { unsigned u = __builtin_bit_cast(unsigned, f); return (u + 0x7fffu + ((u >> 16) & 1u)) >> 16; }
__device__ __forceinline__ unsigned pk2(float lo, float hi) { return f2bf(lo) | (f2bf(hi) << 16); }

__device__ __forceinline__ float compute_lam(const Ptrs& P, int lane) {
    const float a = wave_sum(P.lq1[lane] * P.lk1[lane]), c = wave_sum(P.lq2[lane] * P.lk2[lane]);
    return __expf(a) - __expf(c) + LAM_INIT;
}
__device__ __forceinline__ float bflo_(unsigned w) { return __builtin_bit_cast(float, w << 16); }
__device__ __forceinline__ float bfhi_(unsigned w) { return __builtin_bit_cast(float, w & 0xffff0000u); }

#define XB_TMO      128
#define XB_XCNT(j)  (256  + 64 * (j))
#define XB_XSUB(j)  (1280 + 64 * (j))
#define XB_XGEN(j)  (2304 + 64 * (j))
#define XB_TOP      3328
#define XB_TOPGEN   3392
#define XCD_BAR_WORDS 3456
#define XB_SPIN_CAP (1u << 18)

__device__ __forceinline__ unsigned xb_ld(unsigned* p)              { return __hip_atomic_load(p, __ATOMIC_RELAXED, __HIP_MEMORY_SCOPE_AGENT); }
__device__ __forceinline__ unsigned xb_add(unsigned* p, unsigned v) { return __hip_atomic_fetch_add(p, v, __ATOMIC_RELAXED, __HIP_MEMORY_SCOPE_AGENT); }
__device__ __forceinline__ unsigned xb_xcc_id() { return (unsigned)__builtin_amdgcn_s_getreg((3 << 11) | 20) & 0xFu; }
#define XB_SPIN(cond, bar) do { unsigned _sp = 0; while (cond) { __builtin_amdgcn_s_sleep(1); \
    if ((++_sp & 255u) == 0u) { if (xb_ld(&(bar)[XB_TMO])) break; if (_sp > XB_SPIN_CAP) { atomicAdd(&(bar)[XB_TMO], 1u); break; } } } } while (0)

struct XcdBarrier {
    unsigned* bar; unsigned x;
    volatile LAS unsigned* st;
};

__device__ __forceinline__ XcdBarrier xcd_barrier_post(unsigned* bar, volatile LAS unsigned* st) {
    XcdBarrier b; b.bar = bar; b.x = xb_xcc_id(); b.st = st;
    if (threadIdx.x == 0) (void)xb_add(&bar[XB_XCNT(b.x)], 1u);
    return b;
}
__device__ __forceinline__ void xcd_barrier_complete(unsigned* bar, unsigned x, unsigned& nloc, unsigned& nx) {
    const unsigned G = gridDim.x * gridDim.y * gridDim.z;
    unsigned sum, cnt, mine, sp = 0u;
    for (;;) {
        sum = 0u; cnt = 0u; mine = 0u;
#pragma unroll
        for (unsigned j = 0; j < 16; ++j) { const unsigned c = xb_ld(&bar[XB_XCNT(j)]); sum += c; cnt += (c > 0u) ? 1u : 0u; mine = (j == x) ? c : mine; }
        if (sum == G) break;
        __builtin_amdgcn_s_sleep(1);
        if ((++sp & 255u) == 0u) { if (xb_ld(&bar[XB_TMO])) break; if (sp > XB_SPIN_CAP) { atomicAdd(&bar[XB_TMO], 1u); break; } }
    }
    nloc = mine > 0u ? mine : 1u; nx = cnt > 0u ? cnt : 1u;
}

__device__ __forceinline__ void xcd_barrier(const XcdBarrier& b) {
    asm volatile("s_waitcnt vmcnt(0)" ::: "memory");
    __syncthreads();
    if (threadIdx.x == 0) {
        unsigned* bar = b.bar;
        __builtin_amdgcn_s_waitcnt(0);
        unsigned nloc = b.st[0], nx = b.st[1];
        if (nloc == 0u) { xcd_barrier_complete(bar, b.x, nloc, nx); b.st[0] = nloc; b.st[1] = nx; }
        const unsigned old = xb_add(&bar[XB_XSUB(b.x)], 1u);
        const unsigned gen = old / nloc;
        if (old + 1u == (gen + 1u) * nloc) {
            __builtin_amdgcn_fence(__ATOMIC_RELEASE, "agent");
            asm volatile("s_waitcnt vmcnt(0)" ::: "memory");
            const unsigned og = xb_add(&bar[XB_TOP], 1u);
            const unsigned tg = og / nx;
            if (og + 1u == (tg + 1u) * nx) xb_add(&bar[XB_TOPGEN], 1u);
            else XB_SPIN(xb_ld(&bar[XB_TOPGEN]) == tg, bar);
            __builtin_amdgcn_fence(__ATOMIC_ACQUIRE, "agent");
            xb_add(&bar[XB_XGEN(b.x)], 1u);
            asm volatile("s_waitcnt vmcnt(0)" ::: "memory");
        } else {
            XB_SPIN(xb_ld(&bar[XB_XGEN(b.x)]) == gen, bar);
            __builtin_amdgcn_fence(__ATOMIC_ACQUIRE, "agent");
            asm volatile("s_waitcnt vmcnt(0)" ::: "memory");
        }
    }
    __syncthreads();
}

namespace pg8 {
#define PG8_LAS __attribute__((address_space(3)))
typedef unsigned short bf16_t;
typedef short bf16x8 __attribute__((ext_vector_type(8)));
typedef float f32x4 __attribute__((ext_vector_type(4)));
typedef unsigned u32x4 __attribute__((ext_vector_type(4)));
constexpr int BM = 256, BK = 64, HALF = 128, HTB = HALF * BK * 2  , STAGE_BYTES = 8 * HTB, NXCD = 8, WGM = 8;

__host__ __device__ __forceinline__ int lds_byte(int r, int c) { const int st = (r >> 4) * 2 + (c >> 5), rr = r & 15, cc = c & 31, ob = rr * 64 + cc * 2; return st * 1024 + (ob ^ (((ob >> 9) & 1) << 5)); }
__host__ __device__ __forceinline__ void stage_rc(int b, int& R, int& C) { const int st = b / 1024, sb = b % 1024, swz = sb ^ (((sb >> 9) & 1) << 5); R = (st >> 1) * 16 + swz / 64; C = (st & 1) * 32 + (swz % 64) / 2; }
__host__ __device__ __forceinline__ int perm32(int rho) { const int n = rho >> 4, i = rho & 15; return 8 * (i >> 2) + 4 * n + (i & 3); }

struct Unit { int pm, pn; };
struct Gemm { const bf16_t* A; const bf16_t* Bt; int M, N, K; };

struct StaticOrder {
    int nM, nN, nwg, G, c;
    __host__ __device__ void init(int M, int N, int G_, int c_) { nM = M / BM; nN = N / BM; nwg = nM * nN; G = G_; c = c_; }
    __host__ __device__ bool next(int i, Unit& u) const {
        const long L = (long)i * G + c; if (L >= nwg) return false;
        int wgid = (int)L; { const int q = nwg / NXCD, r = nwg % NXCD, xcd = wgid % NXCD, off = wgid / NXCD; wgid = (xcd < r ? xcd * (q + 1) : r * (q + 1) + (xcd - r) * q) + off; }
        const int nig = WGM * nN, gid = wgid / nig, fm = gid * WGM, gsz = (nM - fm) < WGM ? (nM - fm) : WGM;
        u.pm = fm + ((wgid % nig) % gsz); u.pn = (wgid % nig) / gsz; return true;
    }
    __device__ __forceinline__ void a_ready(const Unit&) const {}
    __device__ __forceinline__ void done(const Unit&) const {}
};

typedef float f32x2_t __attribute__((ext_vector_type(2))); typedef __bf16 bf16x2_t __attribute__((ext_vector_type(2)));
__device__ __forceinline__ unsigned cvt_pk_bf16(float lo, float hi) { f32x2_t v = {lo, hi}; bf16x2_t b = __builtin_convertvector(v, bf16x2_t); return __builtin_bit_cast(unsigned, b); }
__device__ __forceinline__ float fast_sigmoid(float v) { return __builtin_amdgcn_rcpf(1.f + __builtin_amdgcn_exp2f(-1.4426950408889634f * v)); }
__device__ __forceinline__ float fast_silu(float v) { return v * fast_sigmoid(v); }
__device__ __forceinline__ u32x4 pack8f(const f32x4 a, const f32x4 b) { u32x4 w; w.x = cvt_pk_bf16(a[0], a[1]); w.y = cvt_pk_bf16(a[2], a[3]); w.z = cvt_pk_bf16(b[0], b[1]); w.w = cvt_pk_bf16(b[2], b[3]); return w; }
__device__ __forceinline__ float bflo(unsigned w) { return __builtin_bit_cast(float, w << 16); }
__device__ __forceinline__ float bfhi(unsigned w) { return __builtin_bit_cast(float, w & 0xffff0000u); }

struct EpiProj {
    static constexpr bool PERM = true, AFTER_DRAIN = false, HAS_MID = false, HAS_INIT = false;
    bf16_t *Q, *KI, *VI, *SG, *U, *GB, *RT, *G1, *BRc; const float *qg, *kg, *cw;
    __device__ __forceinline__ void mid(f32x4 (&)[2][2][4][2], const Unit&, int, int, int, int) const {}
    __device__ __forceinline__ void operator()(f32x4 (&acc)[2][2][4][2], const Unit& u, int wr, int wc, int fr, int fq) const {
        const int b = u.pm >> 4, s0 = (u.pm & 15) * 256, pn = u.pn; int rl0 = wr * 64 + fr; asm volatile("" : "+v"(rl0)); asm volatile("" : "+v"(fq));
        if (pn < 4) {
            const bool isq = pn < 2; const float* gp = isq ? qg : kg;
            f32x4 gv[2][2];
#pragma unroll
            for (int bj = 0; bj < 2; ++bj)
#pragma unroll
                for (int n = 0; n < 2; ++n) gv[bj][n] = *(const f32x4*)(gp + 32 * bj + 8 * fq + 4 * n);
            const int grp = (pn & 1) * 4 + wc;
#pragma unroll
            for (int ai = 0; ai < 2; ++ai)
#pragma unroll
                for (int m = 0; m < 4; ++m) {
                    float ss = 0.f;
#pragma unroll
                    for (int bj = 0; bj < 2; ++bj)
#pragma unroll
                        for (int n = 0; n < 2; ++n) { const f32x4 x = acc[ai][bj][m][n]; ss += (x[0] * x[0] + x[1] * x[1]) + (x[2] * x[2] + x[3] * x[3]); }
                    ss += __shfl_xor(ss, 16); ss += __shfl_xor(ss, 32);
                    const float sc = rsqrtf(ss * (1.f / 64.f) + EPS) * (isq ? C2 : 1.f);
                    const int rl = rl0 + 128 * ai + 16 * m;
#pragma unroll
                    for (int bj = 0; bj < 2; ++bj) {
                        const u32x4 w = pack8f(acc[ai][bj][m][0] * sc * gv[bj][0], acc[ai][bj][m][1] * sc * gv[bj][1]);
                        if (isq) *(u32x4*)(Q + (size_t)(u.pm * 256 + rl) * AW + grp * 64 + 32 * bj + 8 * fq) = w;
                        else *(u32x4*)(KI + kimg_off(b, grp >> 1, grp & 1, s0 + rl + NMETA, 32 * bj + 8 * fq)) = w;
                    }
                }
        } else if (pn < 6) {
#pragma unroll
            for (int ai = 0; ai < 2; ++ai)
#pragma unroll
                for (int m = 0; m < 4; ++m) { const int rl = rl0 + 128 * ai + 16 * m;
#pragma unroll
                    for (int bj = 0; bj < 2; ++bj)
                        *(u32x4*)(VI + vimg_off(b, (pn - 4) * 2 + bj, s0 + rl + NMETA, 32 * wc + 8 * fq)) = pack8f(acc[ai][bj][m][0], acc[ai][bj][m][1]);
                }
        } else if (pn < 8) {
#pragma unroll
            for (int ai = 0; ai < 2; ++ai)
#pragma unroll
                for (int m = 0; m < 4; ++m) { const int rl = rl0 + 128 * ai + 16 * m;
#pragma unroll
                    for (int bj = 0; bj < 2; ++bj) { f32x4 a = acc[ai][bj][m][0], c = acc[ai][bj][m][1];
#pragma unroll
                        for (int i = 0; i < 4; ++i) { a[i] = fast_silu(a[i]); c[i] = fast_silu(c[i]); }
                        *(u32x4*)(SG + (size_t)(u.pm * 256 + rl) * AW + (pn - 6) * 256 + 128 * bj + 32 * wc + 8 * fq) = pack8f(a, c); }
                }
        } else if (pn < 16) {
            const int ch0 = 64 * (pn - 8) + 16 * wc + 4 * fq;
            const f32x4 w0 = *(const f32x4*)(cw + ch0), w1 = *(const f32x4*)(cw + CW + ch0), w2 = *(const f32x4*)(cw + 2 * CW + ch0);
#pragma unroll
            for (int ai = 0; ai < 2; ++ai) {
                f32x4 uu[4];
#pragma unroll
                for (int m = 0; m < 4; ++m) uu[m] = acc[ai][0][m][0] * acc[ai][0][m][1];
#pragma unroll
                for (int m = 0; m < 4; ++m) { const int rl = rl0 + 128 * ai + 16 * m;
                    f32x4 g = acc[ai][1][m][1];
#pragma unroll
                    for (int i = 0; i < 4; ++i) g[i] = fast_silu(g[i]);
                    const f32x4 gb = acc[ai][1][m][0] * g;
                    f32x4 u1, u2;
#pragma unroll
                    for (int i = 0; i < 4; ++i) {
                        const float pv_ = uu[m > 0 ? m - 1 : 0][i], cu_ = uu[m][i];
                        const int ln = threadIdx.x & 63;
                        const float a1 = __shfl(cu_, ln - 1), b1 = __shfl(pv_, ln + 15), a2 = __shfl(cu_, ln - 2), b2 = __shfl(pv_, ln + 14);
                        u1[i] = fr >= 1 ? a1 : b1; u2[i] = fr >= 2 ? a2 : b2;
                    }
                    const f32x4 cv = gb * (w0 * u2 + w1 * u1 + w2 * uu[m]);
                    const int r64 = 16 * m + fr;
                    if (r64 >= 2) { uint2 wc_; wc_.x = cvt_pk_bf16(cv[0], cv[1]); wc_.y = cvt_pk_bf16(cv[2], cv[3]); typedef unsigned u32x2_t __attribute__((ext_vector_type(2))); __builtin_nontemporal_store((u32x2_t){wc_.x, wc_.y}, (u32x2_t*)(BRc + (size_t)(u.pm * 256 + rl) * 1024 + 512 + ch0)); }
                    if (r64 < 2 || r64 >= 62) { uint2 wu; wu.x = cvt_pk_bf16(uu[m][0], uu[m][1]); wu.y = cvt_pk_bf16(uu[m][2], uu[m][3]); *(uint2*)(U + ((size_t)b * LTOK + s0 + rl + NMETA) * CW + ch0) = wu; }
                    if (r64 < 2) { uint2 wg; wg.x = cvt_pk_bf16(gb[0], gb[1]); wg.y = cvt_pk_bf16(gb[2], gb[3]); *(uint2*)(GB + (size_t)(u.pm * 256 + rl) * CW + ch0) = wg; }
                }
            }
        } else {
            const int j0 = 128 * (pn - 16) + 32 * wc + 8 * fq;
#pragma unroll
            for (int ai = 0; ai < 2; ++ai)
#pragma unroll
                for (int m = 0; m < 4; ++m) { const int rl = rl0 + 128 * ai + 16 * m;
                    f32x4 rt[2], s1[2];
#pragma unroll
                    for (int n = 0; n < 2; ++n)
#pragma unroll
                        for (int i = 0; i < 4; ++i) {
                            const float g0 = fminf(fmaxf(acc[ai][0][m][n][i], -30.f), 30.f), g1 = fminf(fmaxf(acc[ai][1][m][n][i], -30.f), 30.f);
                            const float e0 = __builtin_amdgcn_exp2f(-1.4426950408889634f * g0), e1 = __builtin_amdgcn_exp2f(-1.4426950408889634f * g1);
                            rt[n][i] = (1.f + e1) * __builtin_amdgcn_rcpf(1.f + e0); s1[n][i] = __builtin_amdgcn_rcpf(1.f + e1); }
                    __builtin_nontemporal_store(pack8f(rt[0], rt[1]), (u32x4*)(RT + (size_t)(u.pm * 256 + rl) * DM + j0));
                    __builtin_nontemporal_store(pack8f(s1[0], s1[1]), (u32x4*)(G1 + (size_t)(u.pm * 256 + rl) * DM + j0));
                }
        }
    }
};

struct EpiMerge {
    static constexpr bool PERM = true, AFTER_DRAIN = false, HAS_MID = true, HAS_INIT = false;
    const bf16_t* RT; const bf16_t* G1; bf16_t* MG;
#ifdef PROBE_P3CYC
    unsigned long long* wc;
#endif
    __device__ __forceinline__ void scale(f32x4 (&acc)[2][2][4][2], const bf16_t* G, const Unit& u, int wr, int wc, int fr, int fq) const {
        u32x4 gv[2][4][2];
#pragma unroll
        for (int ai = 0; ai < 2; ++ai)
#pragma unroll
            for (int m = 0; m < 4; ++m) { const size_t row = (size_t)u.pm * 256 + 128 * ai + 64 * wr + 16 * m + fr;
#pragma unroll
                for (int bj = 0; bj < 2; ++bj) gv[ai][m][bj] = __builtin_nontemporal_load((const u32x4*)(G + row * DM + u.pn * 256 + 128 * bj + 32 * wc + 8 * fq)); }
#pragma unroll
        for (int ai = 0; ai < 2; ++ai)
#pragma unroll
            for (int m = 0; m < 4; ++m)
#pragma unroll
                for (int bj = 0; bj < 2; ++bj) { const u32x4 a = gv[ai][m][bj];
                    acc[ai][bj][m][0] *= (f32x4){bflo(a.x), bfhi(a.x), bflo(a.y), bfhi(a.y)}; acc[ai][bj][m][1] *= (f32x4){bflo(a.z), bfhi(a.z), bflo(a.w), bfhi(a.w)}; }
    }
    __device__ __forceinline__ void mid(f32x4 (&acc)[2][2][4][2], const Unit& u, int wr, int wc, int fr, int fq) const {
        asm volatile("" : "+v"(fr)); asm volatile("" : "+v"(fq));
#ifdef PROBE_P3CYC
        const unsigned long long t0_ = __builtin_amdgcn_s_memtime();
#endif
        scale(acc, RT, u, wr, wc, fr, fq);
#ifdef PROBE_P3CYC
        asm volatile("" : "+v"(acc[0][0][0][0])); if (blockIdx.x == 0 && threadIdx.x == 0) *this->wc += __builtin_amdgcn_s_memtime() - t0_;
#endif
    }
    __device__ __forceinline__ void operator()(f32x4 (&acc)[2][2][4][2], const Unit& u, int wr, int wc, int fr, int fq) const {
        asm volatile("" : "+v"(fr)); asm volatile("" : "+v"(fq));
        scale(acc, G1, u, wr, wc, fr, fq);
#pragma unroll
        for (int ai = 0; ai < 2; ++ai)
#pragma unroll
            for (int m = 0; m < 4; ++m) { const size_t row = (size_t)u.pm * 256 + 128 * ai + 64 * wr + 16 * m + fr;
#pragma unroll
                for (int bj = 0; bj < 2; ++bj) *(u32x4*)(MG + row * DM + u.pn * 256 + 128 * bj + 32 * wc + 8 * fq) = pack8f(acc[ai][bj][m][0], acc[ai][bj][m][1]); }
    }
};

struct EpiOut {
    static constexpr bool PERM = false, AFTER_DRAIN = false, HAS_MID = false, HAS_INIT = true;
    const float* x; float* out;
    __device__ __forceinline__ void mid(f32x4 (&)[2][2][4][2], const Unit&, int, int, int, int) const {}
    __device__ __forceinline__ void init(f32x4 (&acc)[2][2][4][2], const Unit& u, int wr, int wc, int fr, int fq) const {
        asm volatile("" : "+v"(fr)); asm volatile("" : "+v"(fq));
#pragma unroll
        for (int ai = 0; ai < 2; ++ai)
#pragma unroll
            for (int m = 0; m < 4; ++m) { const size_t off = ((size_t)u.pm * 256 + 128 * ai + 64 * wr + 16 * m + fr) * DM + u.pn * 256 + 32 * wc + 4 * fq;
#pragma unroll
                for (int bj = 0; bj < 2; ++bj)
#pragma unroll
                    for (int n = 0; n < 2; ++n) acc[ai][bj][m][n] = __builtin_nontemporal_load((const f32x4*)(x + off + bj * HALF + n * 16)); }
    }
    __device__ __forceinline__ void operator()(f32x4 (&acc)[2][2][4][2], const Unit& u, int wr, int wc, int fr, int fq) const {
        asm volatile("" : "+v"(fr)); asm volatile("" : "+v"(fq));
#pragma unroll
        for (int ai = 0; ai < 2; ++ai)
#pragma unroll
            for (int m = 0; m < 4; ++m) { const size_t off = ((size_t)u.pm * 256 + 128 * ai + 64 * wr + 16 * m + fr) * DM + u.pn * 256 + 32 * wc + 4 * fq;
#pragma unroll
                for (int bj = 0; bj < 2; ++bj)
#pragma unroll
                    for (int n = 0; n < 2; ++n) *(f32x4*)(out + off + bj * HALF + n * 16) = acc[ai][bj][m][n]; }
    }
};

template <class Epi, class Sched, bool ALIGN_EPI = false, bool SP2 = false>
__device__ __forceinline__ void gemm_phase(PG8_LAS unsigned char* lds, const Gemm g, const Sched& S, const Epi& E) {
    const int tid = threadIdx.x, wid = __builtin_amdgcn_readfirstlane(tid >> 6), lane = tid & 63, wr = wid >> 2, wc = wid & 3, fr = lane & 15, fq = lane >> 4;
    const int K = g.K, nt = K / BK;
    unsigned voffA[2], voffB[2];
#pragma unroll
    for (int i = 0; i < 2; ++i) { int R, C; stage_rc(tid * 16 + i * 8192, R, C); const int Rb = Epi::PERM ? ((R & ~31) + perm32(R & 31)) : R;
        voffA[i] = (unsigned)(R * K + C) * 2u; voffB[i] = (unsigned)(Rb * K + C) * 2u; }
    const size_t kstep = (size_t)(BK * 2);
    const size_t hstep = (size_t)HALF * K * 2;
    const size_t tstep = 2 * hstep;
    const unsigned ldsw = (unsigned)wid * 1024u;
    const int aoff = lds_byte(wr * 64 + fr, fq * 8), boff = lds_byte(wc * 32 + fr, fq * 8);
#define PG8_SA(b, h) (((b) * 2 + (h)) * HTB)
#define PG8_SB(b, h) ((4 + (b) * 2 + (h)) * HTB)
#define PG8_STAGE(bufoff, gbase, voff) do { _Pragma("unroll") for (int _i = 0; _i < 2; ++_i) \
        __builtin_amdgcn_global_load_lds((const unsigned*)((const char*)(gbase) + (voff)[_i]), (PG8_LAS unsigned*)(lds + (bufoff) + ldsw + _i * 8192), 16, 0, 0); } while (0)
#define PG8_LDA(dst, b, h) do { _Pragma("unroll") for (int m = 0; m < 4; ++m) _Pragma("unroll") for (int k = 0; k < 2; ++k) dst[m][k] = *(const PG8_LAS bf16x8*)(lds + PG8_SA(b, h) + aoff + m * 2048 + k * 1024); } while (0)
#define PG8_LDB(dst, b, h) do { _Pragma("unroll") for (int n = 0; n < 2; ++n) _Pragma("unroll") for (int k = 0; k < 2; ++k) dst[n][k] = *(const PG8_LAS bf16x8*)(lds + PG8_SB(b, h) + boff + n * 2048 + k * 1024); } while (0)
#define PG8_MMA(ai, bj, At, Bt) do { __builtin_amdgcn_s_setprio(1); _Pragma("unroll") for (int m = 0; m < 4; ++m) _Pragma("unroll") for (int n = 0; n < 2; ++n) _Pragma("unroll") for (int k = 0; k < 2; ++k) \
        acc[ai][bj][m][n] = __builtin_amdgcn_mfma_f32_16x16x32_bf16(Bt[n][k], At[m][k], acc[ai][bj][m][n], 0, 0, 0); __builtin_amdgcn_s_setprio(0); } while (0)
#define PG8_WAIT_V(n) asm volatile("s_waitcnt vmcnt(" #n ")" ::: "memory")
#define PG8_WAIT_L(n) asm volatile("s_waitcnt lgkmcnt(" #n ")" ::: "memory")
#define PG8_BAR __builtin_amdgcn_s_barrier()
#define PG8_SCHED __builtin_amdgcn_sched_barrier(0)
    Unit cur, nxt; int ui = 0;
    if (!S.next(0, cur)) return;
    f32x4 acc[2][2][4][2];
#pragma unroll
    for (int a = 0; a < 2; ++a)
#pragma unroll
        for (int b = 0; b < 2; ++b)
#pragma unroll
            for (int m = 0; m < 4; ++m)
#pragma unroll
                for (int n = 0; n < 2; ++n) acc[a][b][m][n] = (f32x4){0.f, 0.f, 0.f, 0.f};
    if constexpr (Epi::HAS_INIT) E.init(acc, cur, wr, wc, fr, fq);
    bf16x8 At[4][2], B0[2][2], B1[2][2];
    const char* cA = (const char*)g.A + (size_t)cur.pm * tstep; const char* cB = (const char*)g.Bt + (size_t)cur.pn * tstep;
    S.a_ready(cur);
    if constexpr (SP2) {
        PG8_STAGE(PG8_SB(0, 0), cB, voffB); PG8_STAGE(PG8_SB(0, 1), cB + hstep, voffB); PG8_STAGE(PG8_SA(0, 0), cA, voffA); PG8_STAGE(PG8_SA(0, 1), cA + hstep, voffA);
        if (wr == 1) PG8_BAR;
        PG8_WAIT_V(2); PG8_BAR;
        PG8_STAGE(PG8_SB(1, 0), cB + kstep, voffB); PG8_STAGE(PG8_SA(1, 0), cA + kstep, voffA); PG8_STAGE(PG8_SB(1, 1), cB + hstep + kstep, voffB);
        PG8_WAIT_V(6); PG8_BAR;
    } else {
        PG8_STAGE(PG8_SB(0, 0), cB, voffB); PG8_STAGE(PG8_SA(0, 0), cA, voffA); PG8_STAGE(PG8_SB(0, 1), cB + hstep, voffB); PG8_STAGE(PG8_SA(0, 1), cA + hstep, voffA);
        if (wr == 1) PG8_BAR;
        PG8_WAIT_V(4); PG8_BAR;
        PG8_STAGE(PG8_SB(1, 0), cB + kstep, voffB); PG8_STAGE(PG8_SA(1, 0), cA + kstep, voffA); PG8_STAGE(PG8_SB(1, 1), cB + hstep + kstep, voffB);
        PG8_WAIT_V(6); PG8_BAR;
    }
    for (;;) {
        const bool has_next = S.next(ui + 1, nxt);
        const char* nA = has_next ? (const char*)g.A + (size_t)nxt.pm * tstep : cA; const char* nB = has_next ? (const char*)g.Bt + (size_t)nxt.pn * tstep : cB;
        for (int t = 0; t < nt; t += 2) {
            if constexpr (Epi::HAS_MID) { if (t == nt / 2) E.mid(acc, cur, wr, wc, fr, fq); }
            const bool last = (t == nt - 2);
            const char* a1 = cA + (size_t)(t + 1) * kstep;
            const char* a2 = last ? nA : cA + (size_t)(t + 2) * kstep; const char* b2 = last ? nB : cB + (size_t)(t + 2) * kstep;
            const char* a3 = a2 + kstep; const char* b3 = b2 + kstep;
            if (last && has_next) S.a_ready(nxt);
            if constexpr (SP2) {
            PG8_LDB(B0, 0, 0); PG8_LDB(B1, 0, 1); PG8_SCHED; PG8_LDA(At, 0, 0); PG8_STAGE(PG8_SA(1, 1), a1 + hstep, voffA);
            PG8_WAIT_V(8); PG8_WAIT_L(0); PG8_BAR; PG8_MMA(0, 0, At, B0); PG8_MMA(0, 1, At, B1); PG8_BAR; PG8_SCHED;
            PG8_LDA(At, 0, 1); PG8_STAGE(PG8_SB(0, 0), b2, voffB); PG8_STAGE(PG8_SB(0, 1), b2 + hstep, voffB); PG8_STAGE(PG8_SA(0, 0), a2, voffA);
            PG8_WAIT_V(8); PG8_WAIT_L(0); PG8_BAR; PG8_MMA(1, 0, At, B0); PG8_MMA(1, 1, At, B1); PG8_BAR; PG8_SCHED;
            PG8_LDB(B0, 1, 0); PG8_LDB(B1, 1, 1); PG8_SCHED; PG8_LDA(At, 1, 0); PG8_STAGE(PG8_SA(0, 1), a2 + hstep, voffA);
            PG8_WAIT_V(8); PG8_WAIT_L(0); PG8_BAR; PG8_MMA(0, 0, At, B0); PG8_MMA(0, 1, At, B1); PG8_BAR; PG8_SCHED;
            PG8_LDA(At, 1, 1); PG8_STAGE(PG8_SB(1, 0), b3, voffB); PG8_STAGE(PG8_SB(1, 1), b3 + hstep, voffB); PG8_STAGE(PG8_SA(1, 0), a3, voffA);
            PG8_WAIT_V(8); PG8_WAIT_L(0); PG8_BAR; PG8_MMA(1, 0, At, B0); PG8_MMA(1, 1, At, B1); PG8_BAR; PG8_SCHED;
            } else {
            PG8_LDB(B0, 0, 0); PG8_SCHED; PG8_LDA(At, 0, 0); PG8_STAGE(PG8_SA(1, 1), a1 + hstep, voffA);
            PG8_WAIT_L(8); PG8_BAR; PG8_WAIT_L(0); PG8_MMA(0, 0, At, B0); PG8_BAR; PG8_SCHED;
            PG8_LDB(B1, 0, 1); PG8_STAGE(PG8_SB(0, 0), b2, voffB);
            PG8_BAR; PG8_WAIT_L(0); PG8_MMA(0, 1, At, B1); PG8_BAR;
            PG8_LDA(At, 0, 1); PG8_STAGE(PG8_SA(0, 0), a2, voffA);
            PG8_BAR; PG8_WAIT_L(0); PG8_MMA(1, 0, At, B0); PG8_BAR; PG8_SCHED;
            PG8_STAGE(PG8_SB(0, 1), b2 + hstep, voffB);
            PG8_WAIT_V(6); PG8_BAR; PG8_MMA(1, 1, At, B1); PG8_BAR;
            PG8_LDB(B0, 1, 0); PG8_SCHED; PG8_LDA(At, 1, 0); PG8_STAGE(PG8_SA(0, 1), a2 + hstep, voffA);
            PG8_WAIT_L(8); PG8_BAR; PG8_WAIT_L(0); PG8_MMA(0, 0, At, B0); PG8_BAR; PG8_SCHED;
            PG8_LDB(B1, 1, 1); PG8_STAGE(PG8_SB(1, 0), b3, voffB);
            PG8_BAR; PG8_WAIT_L(0); PG8_MMA(0, 1, At, B1); PG8_BAR;
            PG8_LDA(At, 1, 1); PG8_STAGE(PG8_SA(1, 0), a3, voffA);
            PG8_BAR; PG8_WAIT_L(0); PG8_MMA(1, 0, At, B0); PG8_BAR; PG8_SCHED;
            PG8_STAGE(PG8_SB(1, 1), b3 + hstep, voffB);
            PG8_WAIT_V(6); PG8_BAR; PG8_MMA(1, 1, At, B1); PG8_BAR;
            }
        }
        if constexpr (ALIGN_EPI) { if (wr == 0) PG8_BAR; }
        if constexpr (!Epi::AFTER_DRAIN) { E(acc, cur, wr, wc, fr, fq); S.done(cur); }
        if (!has_next) break;
#pragma unroll
        for (int a = 0; a < 2; ++a)
#pragma unroll
            for (int b = 0; b < 2; ++b)
#pragma unroll
                for (int m = 0; m < 4; ++m)
#pragma unroll
                    for (int n = 0; n < 2; ++n) acc[a][b][m][n] = (f32x4){0.f, 0.f, 0.f, 0.f};
        if constexpr (Epi::HAS_INIT) E.init(acc, nxt, wr, wc, fr, fq);
        cur = nxt; cA = nA; cB = nB; ++ui;
        if constexpr (ALIGN_EPI) { if (wr == 1) PG8_BAR; }
    }
    PG8_WAIT_V(0);
    if constexpr (!ALIGN_EPI) { if (wr == 0) PG8_BAR; }
    PG8_BAR;
    static_assert(!Epi::AFTER_DRAIN, "no after-drain epilogues in this kernel");
#undef PG8_SA
#undef PG8_SB
#undef PG8_STAGE
#undef PG8_LDA
#undef PG8_LDB
#undef PG8_MMA
#undef PG8_WAIT_V
#undef PG8_WAIT_L
#undef PG8_BAR
#undef PG8_SCHED
}
}

namespace dattn {
using bf16x8 = __attribute__((ext_vector_type(8))) short;
using s16x4 = __attribute__((ext_vector_type(4))) short;
using f32x16 = __attribute__((ext_vector_type(16))) float;
using f32x4 = __attribute__((ext_vector_type(4))) float;
using u32x4 = __attribute__((ext_vector_type(4))) unsigned;
constexpr int NW = 8, QBLK = 32, KVBLK = 64, QB = 256;
constexpr int SHM_V = 16384, SHM_K = 8192;
constexpr int NSLOT = 3;
constexpr int L_V = 0, L_K = NSLOT * SHM_V, L_WS = L_K + NSLOT * SHM_K, L_TAB = L_WS + NW * 256, L_O0 = L_TAB + 2 * 2048, L_MISC = L_O0 + NW * 8192, L_END = L_MISC + 1024;
constexpr int TAB_OFF = 304;
constexpr float THR = 8.f;
#define SBAR() __builtin_amdgcn_sched_barrier(0)
__device__ __forceinline__ int v_rd_base(int lane) { return ((lane & 3) << 3) | (((lane >> 2) & 3) << 6) | (((lane >> 4) & 1) << 5) | (((lane >> 5) & 1) << 8); }
constexpr int v_rd_off(int d0, int ks, int half) { return d0 * 512 + ks * 4096 + half * 2048; }
__device__ __forceinline__ int crow(int r, int hi) { return (r & 3) + 8 * (r >> 2) + 4 * hi; }
__device__ __forceinline__ unsigned cvtpk(float lo, float hi) { return pg8::cvt_pk_bf16(lo, hi); }

__device__ __forceinline__ void startSM(f32x16& p0, f32x16& p1, bool near, const char* tabp, float shift) {
    if (near) {
#pragma unroll
        for (int r = 0; r < 16; ++r) { const int c = (r & 3) + 8 * (r >> 2);
            p0[r] += *(const float*)(tabp + 4 * (59 - c)); p1[r] += *(const float*)(tabp + 4 * (59 - c - 32)); }
    }
#if 1
    else if (__builtin_expect(shift != 0.f, 0)) {
#pragma unroll
        for (int r = 0; r < 16; ++r) { p0[r] -= shift; p1[r] -= shift; }
    }
#endif
#pragma unroll
    for (int r = 0; r < 16; ++r) p0[r] = __builtin_amdgcn_exp2f(p0[r]);
}
template <bool EXP1>
__device__ __forceinline__ void finishSM(f32x16& p0, f32x16& p1, float& l_reg, bf16x8& pa0, bf16x8& pa1, bf16x8& pa2, bf16x8& pa3) {
    if constexpr (EXP1) {
#pragma unroll
        for (int r = 0; r < 16; ++r) p1[r] = __builtin_amdgcn_exp2f(p1[r]); }
    float ps = 0;
#pragma unroll
    for (int r = 0; r < 16; ++r) ps += p0[r];
#pragma unroll
    for (int r = 0; r < 16; ++r) ps += p1[r];
    l_reg += ps;
#define PK4(P, B_, OUT) do { unsigned a0 = cvtpk(P[B_+0], P[B_+1]), a1 = cvtpk(P[B_+2], P[B_+3]);                          \
        unsigned b0 = cvtpk(P[B_+4], P[B_+5]), b1 = cvtpk(P[B_+6], P[B_+7]);                                             \
        auto r0 = __builtin_amdgcn_permlane32_swap(a0, b0, false, false); auto r1 = __builtin_amdgcn_permlane32_swap(a1, b1, false, false); \
        u32x4 w = {r0[0], r1[0], r0[1], r1[1]}; OUT = *reinterpret_cast<bf16x8*>(&w); } while (0)
    PK4(p0, 0, pa0); PK4(p0, 8, pa1); PK4(p1, 0, pa2); PK4(p1, 8, pa3);
#undef PK4
}
__device__ __forceinline__ void qkt(int kslot, f32x16& p0, f32x16& p1, const char* K_lds, int r32, int hi, const bf16x8* qr) {
    p0 = f32x16{}; p1 = f32x16{};
    const int sw = (r32 >> 1) & 7;
#pragma unroll
    for (int d0 = 0; d0 < 4; ++d0) { const char* a = K_lds + kslot + r32 * 128 + (((2 * d0 + hi) ^ sw) << 4);
        bf16x8 b0 = *reinterpret_cast<const bf16x8*>(a);
        bf16x8 b1 = *reinterpret_cast<const bf16x8*>(a + 32 * 128);
        p0 = __builtin_amdgcn_mfma_f32_32x32x16_bf16(b0, qr[d0], p0, 0, 0, 0);
        p1 = __builtin_amdgcn_mfma_f32_32x32x16_bf16(b1, qr[d0], p1, 0, 0, 0); }
}
__device__ __forceinline__ void pv_tile(f32x16* o, int vb0  , bf16x8 pa0, bf16x8 pa1, bf16x8 pa2, bf16x8 pa3) {
#define TRRD(dst, off) asm volatile("ds_read_b64_tr_b16 %0, %1 offset:%2" : "=&v"(dst) : "v"(vb0), "i"(off) : "memory")
#define PV_D0(d0) do { s16x4 l0, l1, l2, l3, h0, h1, h2, h3; constexpr int b_ = v_rd_off(d0, 0, 0);     \
        TRRD(l0, b_); TRRD(h0, b_ + 2048); TRRD(l1, b_ + 4096); TRRD(h1, b_ + 6144); TRRD(l2, b_ + 8192); TRRD(h2, b_ + 10240); TRRD(l3, b_ + 12288); TRRD(h3, b_ + 14336); \
        asm volatile("s_waitcnt lgkmcnt(0)" ::: "memory"); SBAR();                                                                                    \
        o[d0] = __builtin_amdgcn_mfma_f32_32x32x16_bf16(pa0, (bf16x8){l0[0], l0[1], l0[2], l0[3], h0[0], h0[1], h0[2], h0[3]}, o[d0], 0, 0, 0);   \
        o[d0] = __builtin_amdgcn_mfma_f32_32x32x16_bf16(pa1, (bf16x8){l1[0], l1[1], l1[2], l1[3], h1[0], h1[1], h1[2], h1[3]}, o[d0], 0, 0, 0);   \
        o[d0] = __builtin_amdgcn_mfma_f32_32x32x16_bf16(pa2, (bf16x8){l2[0], l2[1], l2[2], l2[3], h2[0], h2[1], h2[2], h2[3]}, o[d0], 0, 0, 0);   \
        o[d0] = __builtin_amdgcn_mfma_f32_32x32x16_bf16(pa3, (bf16x8){l3[0], l3[1], l3[2], l3[3], h3[0], h3[1], h3[2], h3[3]}, o[d0], 0, 0, 0); } while (0)
    PV_D0(0); PV_D0(1); PV_D0(2); PV_D0(3);
#undef PV_D0
#undef TRRD
}

typedef __attribute__((address_space(3))) const char* lds_cptr;
typedef short v4i16_t __attribute__((ext_vector_type(4)));
__device__ __forceinline__ s16x4 vtr(lds_cptr p) { return __builtin_bit_cast(s16x4, __builtin_amdgcn_ds_read_tr16_b64_v4i16((__attribute__((address_space(3))) v4i16_t*)p)); }
template <int VAR>
__device__ __forceinline__ void step(f32x16& x0, f32x16& x1, f32x16& y0, f32x16& y1, float& l_reg, f32x16* o, const bf16x8* qr,
                                     const char* Kc  , int sw, int hi, lds_cptr vb  ,
                                     bool near, const char* tabp, float shift) {
    bf16x8 ka[4], kb[4], pa0, pa1, pa2, pa3;
    s16x4 lo[4], hv[4];
    unsigned a0, a1, b0, b1;
#define KRD(d0) do { if constexpr (VAR & 4) break; const char* a_ = Kc + (((2 * (d0) + hi) ^ sw) << 4); ka[d0] = *reinterpret_cast<const bf16x8*>(a_); kb[d0] = *reinterpret_cast<const bf16x8*>(a_ + 32 * 128); } while (0)
#define VRD(i) do { if constexpr (VAR & 2) break; lo[(i) & 3] = vtr(vb + v_rd_off((i) >> 2, (i) & 3, 0)); hv[(i) & 3] = vtr(vb + v_rd_off((i) >> 2, (i) & 3, 1)); } while (0)
#define VFR(i) (bf16x8){lo[(i) & 3][0], lo[(i) & 3][1], lo[(i) & 3][2], lo[(i) & 3][3], hv[(i) & 3][0], hv[(i) & 3][1], hv[(i) & 3][2], hv[(i) & 3][3]}
#define SUM4(Y, b) do { if constexpr (!(VAR & 8)) { ps += (Y[b] + Y[(b) + 1]) + (Y[(b) + 2] + Y[(b) + 3]); asm volatile("" : "+v"(ps)); } } while (0)
#define PKA(Y, b) do { if constexpr (!(VAR & 8)) { a0 = cvtpk(Y[b], Y[(b) + 1]); a1 = cvtpk(Y[(b) + 2], Y[(b) + 3]); } } while (0)
#define PKB(Y, b, OUT) do { if constexpr (VAR & 8) { OUT = ka[0]; asm volatile("" : "+v"(OUT)); } else { b0 = cvtpk(Y[b], Y[(b) + 1]); b1 = cvtpk(Y[(b) + 2], Y[(b) + 3]); auto r0_ = __builtin_amdgcn_permlane32_swap(a0, b0, false, false); auto r1_ = __builtin_amdgcn_permlane32_swap(a1, b1, false, false); \
                            u32x4 w_ = {r0_[0], r1_[0], r0_[1], r1_[1]}; OUT = *reinterpret_cast<bf16x8*>(&w_); asm volatile("" : "+v"(OUT)); } } while (0)
#define QKM(X, KF, QF, C) do { if constexpr (VAR & 4) { X = C; asm volatile("" : "+v"(X)); } else X = __builtin_amdgcn_mfma_f32_32x32x16_bf16(KF, QF, C, 0, 0, 0); } while (0)
    float ps = 0.f;
    if constexpr (VAR & 4) { ka[0] = qr[0]; ka[1] = qr[1]; ka[2] = qr[2]; ka[3] = qr[3]; kb[0] = qr[0]; kb[1] = qr[1]; kb[2] = qr[2]; kb[3] = qr[3]; }
    KRD(0); KRD(1); SBAR();
    { const f32x16 z = f32x16{};
      QKM(x0, ka[0], qr[0], z);  SUM4(y0, 0); PKA(y0, 0);       SBAR();
      QKM(x1, kb[0], qr[0], z);  SUM4(y0, 4); PKB(y0, 4, pa0);  KRD(2); SBAR(); }
    QKM(x0, ka[1], qr[1], x0); SUM4(y0, 8); PKA(y0, 8);       SBAR();
    QKM(x1, kb[1], qr[1], x1); SUM4(y0, 12); PKB(y0, 12, pa1); KRD(3); SBAR();
    QKM(x0, ka[2], qr[2], x0); SUM4(y1, 0); PKA(y1, 0);       SBAR();
    QKM(x1, kb[2], qr[2], x1); SUM4(y1, 4); PKB(y1, 4, pa2);  SBAR();
    QKM(x0, ka[3], qr[3], x0); SUM4(y1, 8); PKA(y1, 8);       SBAR();
    QKM(x1, kb[3], qr[3], x1); SUM4(y1, 12); PKB(y1, 12, pa3); VRD(0); VRD(1); SBAR();
    VRD(2); VRD(3); SBAR();
    if (near) {
        asm volatile("s_nop 15\n\ts_nop 7" : "+v"(x0), "+v"(x1));
#pragma unroll
        for (int r = 0; r < 16; ++r) { const int c = (r & 3) + 8 * (r >> 2);
            const float t0 = *(const float*)(tabp + 4 * (59 - c)), t1 = *(const float*)(tabp + 4 * (59 - c - 32));
            asm volatile("v_add_f32 %0, %0, %1" : "+v"(x0[r]) : "v"(t0)); asm volatile("v_add_f32 %0, %0, %1" : "+v"(x1[r]) : "v"(t1)); }
    } else if (__builtin_expect(shift != 0.f, 0)) {
        asm volatile("s_nop 15\n\ts_nop 7" : "+v"(x0), "+v"(x1));
#pragma unroll
        for (int r = 0; r < 16; ++r) { asm volatile("v_sub_f32 %0, %0, %1" : "+v"(x0[r]) : "v"(shift)); asm volatile("v_sub_f32 %0, %0, %1" : "+v"(x1[r]) : "v"(shift)); }
    }
    SBAR();
#define GAPB(i, PA) do { if constexpr (!(VAR & 2)) o[(i) >> 2] = __builtin_amdgcn_mfma_f32_32x32x16_bf16(PA, VFR(i), o[(i) >> 2], 0, 0, 0); else asm volatile("" :: "v"(PA)); \
                         if constexpr (!(VAR & 1)) { x0[i] = __builtin_amdgcn_exp2f(x0[i]); x1[i] = __builtin_amdgcn_exp2f(x1[i]); } asm volatile("" : "+v"(x0), "+v"(x1)); \
                         if ((i) + 4 < 16) VRD((i) + 4); SBAR(); } while (0)
    GAPB(0, pa0); GAPB(1, pa1); GAPB(2, pa2); GAPB(3, pa3); GAPB(4, pa0); GAPB(5, pa1); GAPB(6, pa2); GAPB(7, pa3);
    GAPB(8, pa0); GAPB(9, pa1); GAPB(10, pa2); GAPB(11, pa3); GAPB(12, pa0); GAPB(13, pa1); GAPB(14, pa2); GAPB(15, pa3);
    l_reg += ps;
#undef QKM
#undef KRD
#undef VRD
#undef VFR
#undef SUM4
#undef PKA
#undef PKB
#undef GAPB
}

struct BlockRef { const bf16_t* Q; const bf16_t* K; const bf16_t* V; int P0; int c; int m0; int h; };
struct Seam { bf16x8 qr[4];
#ifdef PROBE_WAITCYC
    unsigned long long wcyc;
#endif
};
struct Outs { const bf16_t* SG; bf16_t* BR; const float* subg; float lam; };
#define LASP __attribute__((address_space(3)))
#define WAIT_BAR() asm volatile("s_waitcnt vmcnt(0) lgkmcnt(0)\n\ts_barrier" ::: "memory")
#define VMW_N(n) asm volatile("s_waitcnt vmcnt(" #n ")" ::: "memory")
#define WAIT_BAR_N(n) asm volatile("s_waitcnt vmcnt(" #n ") lgkmcnt(0)\n\ts_barrier" ::: "memory")
__device__ __forceinline__ void glds16(const void* gsrc, unsigned lds_dst) { unsigned keep;
    asm volatile("s_mov_b32 %0, m0\n\ts_mov_b32 m0, %2\n\ts_nop 0\n\tglobal_load_lds_dwordx4 %1, off\n\ts_mov_b32 m0, %0" : "=&s"(keep) : "v"(gsrc), "s"(lds_dst) : "memory"); }
#define DMA_K(Kp, j, slot) glds16((const char*)((Kp) + (size_t)(j) * 4096) + tid * 16, (unsigned)__builtin_amdgcn_readfirstlane(lds0 + L_K + (slot) * SHM_K + wid * 1024))
#define DMA_V(Vp, j, slot) do { glds16((const char*)((Vp) + (size_t)(j) * 8192) + tid * 16, (unsigned)__builtin_amdgcn_readfirstlane(lds0 + L_V + (slot) * SHM_V + wid * 1024)); \
                                glds16((const char*)((Vp) + (size_t)(j) * 8192 + 4096) + tid * 16, (unsigned)__builtin_amdgcn_readfirstlane(lds0 + L_V + (slot) * SHM_V + 8192 + wid * 1024)); } while (0)
__device__ __forceinline__ void dattn_issue(const BlockRef& b, char* lds, Seam& S) {
    int tid = threadIdx.x; asm volatile("" : "+v"(tid));
    const int wid = __builtin_amdgcn_readfirstlane(tid >> 6), lane = tid & 63, r32 = lane & 31, hi = lane >> 5;
    const unsigned lds0 = (unsigned)(uintptr_t)lds;
    DMA_K(b.K, 0, 0); DMA_V(b.V, 0, 0); DMA_K(b.K, 1, 1); DMA_V(b.V, 1, 1); DMA_K(b.K, 2, 2);
    int qoff = (wid * QBLK + r32) * AW + hi * 8; asm volatile("" : "+v"(qoff));
#pragma unroll
    for (int d0 = 0; d0 < 4; ++d0) S.qr[d0] = __builtin_nontemporal_load((const bf16x8*)(b.Q + qoff + d0 * 16));
}

#ifdef PROBE_WAITCYC
#define WC0() const unsigned long long wc0_ = __builtin_amdgcn_s_memtime()
#define WC1() S.wcyc += __builtin_amdgcn_s_memtime() - wc0_
#else
#define WC0() do { } while (0)
#define WC1() do { } while (0)
#endif
template <int VAR>
__device__ __forceinline__ void dattn_block(const BlockRef& cur, const BlockRef& nxt, bool has_next, char* lds, Seam& S, const Outs& OU) {
    const int tid = threadIdx.x, wid = __builtin_amdgcn_readfirstlane(tid >> 6), lane = tid & 63, r32 = lane & 31, hi = lane >> 5;
    const int NT = (cur.P0 + QB - 1) / KVBLK + 1;
    const int qlo = cur.P0 + wid * QBLK, qm = qlo + r32 - 4 * hi;
    const unsigned lds0 = (unsigned)(uintptr_t)lds;
    char* V_lds = lds + L_V; char* K_lds = lds + L_K;
    const char* tab = lds + L_TAB + cur.c * 2048;
    const float shift = *(const float*)(lds + L_MISC);
    float l_reg = 0; f32x16 o[4] = {};
    const lds_cptr vb3 = (lds_cptr)V_lds + v_rd_base(lane);
    const int sw = (r32 >> 1) & 7; const char* Kl = K_lds + r32 * 128;
    const bf16_t* Kh = cur.K; const bf16_t* Vh = cur.V;
#define KBASE(t) ((t) * KVBLK)
#define NEAR(t) (KBASE(t) > qlo - 176)
#define TABP(t) (tab + 4 * (qm - KBASE(t) + TAB_OFF - 59))
    f32x16 pA0, pA1, pB0, pB1; bf16x8 pa0, pa1, pa2, pa3;
    int s_prev = 0, s_cur = 0, s_next = 1;
#define ROT() do { s_prev = s_cur; s_cur = s_next; s_next = (s_next == NSLOT - 1) ? 0 : s_next + 1; } while (0)
    WAIT_BAR();
    SBAR(); qkt(0, pA0, pA1, K_lds, r32, hi, S.qr);
    startSM(pA0, pA1, NEAR(0), TABP(0), shift);
#pragma unroll
    for (int r = 0; r < 16; ++r) pA1[r] = __builtin_amdgcn_exp2f(pA1[r]);
    WAIT_BAR();
    ROT();
#define STEP(PX0, PX1, PY0, PY1, t) do {                                                                                      \
        if ((t) + 2 < NT) DMA_K(Kh, (t) + 2, s_prev);                                                                         \
        if ((t) + 1 < NT) DMA_V(Vh, (t) + 1, s_next);                                                                         \
        SBAR();                                                                                                               \
        step<VAR>(PX0, PX1, PY0, PY1, l_reg, o, S.qr, Kl + s_cur * SHM_K, sw, hi, vb3 + s_prev * SHM_V, NEAR(t), TABP(t), shift);         \
          \
        WC0(); if ((t) + 2 < NT) { VMW_N(3); } else if ((t) + 1 < NT) { VMW_N(2); } else { VMW_N(0); } WC1();     \
        asm volatile("s_waitcnt lgkmcnt(0)\n\ts_barrier" ::: "memory"); ROT(); } while (0)
    int t = 1;
    for (; t + 1 < NT; t += 2) { STEP(pB0, pB1, pA0, pA1, t); STEP(pA0, pA1, pB0, pB1, t + 1); }
    if (t < NT) {
        STEP(pB0, pB1, pA0, pA1, t);
        pA0 = pB0; pA1 = pB1;
    }
    int tid_t = threadIdx.x; asm volatile("" : "+v"(tid_t));
    const int lane_t = tid_t & 63, r32_t = lane_t & 31, hi_t = lane_t >> 5;
    const int vb0_t = (int)(uintptr_t)V_lds + v_rd_base(lane_t) + s_prev * SHM_V;
    finishSM<false>(pA0, pA1, l_reg, pa0, pa1, pa2, pa3); SBAR();
    pv_tile(o, vb0_t, pa0, pa1, pa2, pa3);
    WAIT_BAR();
    if (has_next) dattn_issue(nxt, lds, S);
    { auto rr = __builtin_amdgcn_permlane32_swap(__float_as_uint(l_reg), __float_as_uint(l_reg), false, false); l_reg = __uint_as_float(rr[0]) + __uint_as_float(rr[1]); }
    float* li_l = (float*)(lds + L_WS) + wid * 64;
    if (hi_t == 0) li_l[r32_t] = l_reg; asm volatile("s_waitcnt lgkmcnt(0)" ::: "memory");
    float rli[16];
#pragma unroll
    for (int r = 0; r < 16; ++r) rli[r] = __builtin_amdgcn_rcpf(li_l[crow(r, hi_t)]);
    unsigned* o0w = (unsigned*)(lds + L_O0 + wid * 8192);
    if (cur.c == 0) {
#pragma unroll
        for (int d0 = 0; d0 < 4; ++d0)
#pragma unroll
            for (int r = 0; r < 16; r += 2) o0w[(d0 * 8 + (r >> 1)) * 64 + lane_t] = cvtpk(o[d0][r] * rli[r], o[d0][r + 1] * rli[r + 1]);
    } else {
        const float lam = OU.lam;
#pragma unroll
        for (int d0 = 0; d0 < 4; ++d0)
#pragma unroll
            for (int r = 0; r < 16; r += 2) { const unsigned w = o0w[(d0 * 8 + (r >> 1)) * 64 + lane_t];
                o[d0][r] = __builtin_bit_cast(float, w << 16) - lam * (o[d0][r] * rli[r]);
                o[d0][r + 1] = __builtin_bit_cast(float, w & 0xffff0000u) - lam * (o[d0][r + 1] * rli[r + 1]); }
        asm volatile("s_waitcnt lgkmcnt(0)" ::: "memory");
#pragma unroll
        for (int r = 0; r < 16; ++r) {
            float s = (o[0][r] * o[0][r] + o[1][r] * o[1][r]) + (o[2][r] * o[2][r] + o[3][r] * o[3][r]);
            s += __shfl_xor(s, 1); s += __shfl_xor(s, 2); s += __shfl_xor(s, 4); s += __shfl_xor(s, 8); s += __shfl_xor(s, 16);
            const float rn = rsqrtf(s * (1.f / 128.f) + EPS);
#pragma unroll
            for (int d0 = 0; d0 < 4; ++d0) o[d0][r] *= rn;
        }
        unsigned short* stg = (unsigned short*)o0w;
#pragma unroll
        for (int r = 0; r < 16; ++r) { const int orow = crow(r, hi_t);
#pragma unroll
            for (int d0 = 0; d0 < 4; ++d0) stg[orow * 128 + d0 * 32 + r32_t] = (unsigned short)(cvtpk(o[d0][r], 0.f) & 0xffffu); }
        asm volatile("s_waitcnt lgkmcnt(0)" ::: "memory");
        const int ch = lane_t & 15;
        const f32x4 sg0 = *(const f32x4*)(OU.subg + ch * 8), sg1 = *(const f32x4*)(OU.subg + ch * 8 + 4);
#pragma unroll
        for (int i = 0; i < 8; ++i) { const int row = i * 4 + (lane_t >> 4);
            const u32x4 v = *(const u32x4*)(stg + row * 128 + ch * 8);
            const size_t mrow = (size_t)cur.m0 + wid * QBLK + row;
            const u32x4 g = __builtin_nontemporal_load((const u32x4*)(OU.SG + mrow * AW + cur.h * 128 + ch * 8));
            constexpr float SC = 1.f - LAM_INIT;
            u32x4 w;
            w.x = cvtpk(__builtin_bit_cast(float, v.x << 16) * __builtin_bit_cast(float, g.x << 16) * (sg0[0] * SC), __builtin_bit_cast(float, v.x & 0xffff0000u) * __builtin_bit_cast(float, g.x & 0xffff0000u) * (sg0[1] * SC));
            w.y = cvtpk(__builtin_bit_cast(float, v.y << 16) * __builtin_bit_cast(float, g.y << 16) * (sg0[2] * SC), __builtin_bit_cast(float, v.y & 0xffff0000u) * __builtin_bit_cast(float, g.y & 0xffff0000u) * (sg0[3] * SC));
            w.z = cvtpk(__builtin_bit_cast(float, v.z << 16) * __builtin_bit_cast(float, g.z << 16) * (sg1[0] * SC), __builtin_bit_cast(float, v.z & 0xffff0000u) * __builtin_bit_cast(float, g.z & 0xffff0000u) * (sg1[1] * SC));
            w.w = cvtpk(__builtin_bit_cast(float, v.w << 16) * __builtin_bit_cast(float, g.w << 16) * (sg1[2] * SC), __builtin_bit_cast(float, v.w & 0xffff0000u) * __builtin_bit_cast(float, g.w & 0xffff0000u) * (sg1[3] * SC));
            *(u32x4*)(OU.BR + mrow * 1024 + cur.h * 128 + ch * 8) = w; }
    }
    asm volatile("s_waitcnt lgkmcnt(0)" ::: "memory");
#undef KBASE
#undef NEAR
#undef TABP
#undef ROT
#undef STEP
}
#undef DMA_K
#undef DMA_V
#undef WAIT_BAR
#undef WAIT_BAR_N
#undef VMW_N
#undef LASP
#undef SBAR
}

constexpr int NWAVES = 8;
constexpr int RING_OFF = 0, RING_BYTES = 131072;
constexpr int LDS_BYTES = 163840;
constexpr int LDSCTL_OFF = LDS_BYTES - 1024, MISC_OFF = LDSCTL_OFF + 320;
static_assert(dattn::L_END <= LDSCTL_OFF && RING_BYTES <= LDSCTL_OFF, "LDS map");
constexpr int CW_ROWQ = 64;
constexpr int CW_BAR = 4096;
constexpr size_t CTL_ZERO_BYTES = 128 * 1024;

struct Frame {
    LAS unsigned char* lds;
    volatile LAS unsigned* MISC;
    int tid, lane, wave, vcu, G;
};

__device__ __forceinline__ int nat_col(int p) {
    const int pn = p >> 8, t = p & 255;
    if (pn < 4) { const int bj = t >> 7, wc = (t >> 5) & 3, r = t & 31; return pn * 256 + 64 * wc + 32 * bj + r; }
    if (pn >= 8 && pn < 16) { const int bj = t >> 7, wc = (t >> 5) & 3, fq = (t >> 3) & 3, n = (t >> 2) & 1, i = t & 3;
        const int qty = bj == 0 ? (n == 0 ? 1 : 2) : (n == 0 ? 0 : 3);
        return 2048 + 512 * qty + 64 * (pn - 8) + 16 * wc + 4 * fq + i; }
    if (pn >= 16) { const int bj = t >> 7; return 4096 + 1024 * bj + 128 * (pn - 16) + (t & 127); }
    return p;
}
template <bool PERMUTE, bool SCALE>
__device__ __forceinline__ void p0_transpose_wg(Frame& F, const float* W, int K, int N, bf16* WT, const float* g, int item) {
    LAS float* T = (LAS float*)(F.lds + RING_OFF);
    const int nblk = N / 256, kb = item / nblk, nb = item % nblk, k0 = 64 * kb, n0 = 256 * nb;
    const int ncol = PERMUTE ? nat_col(n0 + 4 * F.lane) : n0 + 4 * F.lane;
    f32x4 v[8];
#pragma unroll
    for (int i = 0; i < 8; ++i) v[i] = __builtin_nontemporal_load((const GAS f32x4*)(W + (size_t)(k0 + 8 * F.wave + i) * N + ncol));
#pragma unroll
    for (int i = 0; i < 8; ++i) { const int kk = 8 * F.wave + i; f32x4 x = v[i]; if (SCALE) x = x * g[k0 + kk];
        T[kk * 257 + 4 * F.lane + 0] = x.x; T[kk * 257 + 4 * F.lane + 1] = x.y; T[kk * 257 + 4 * F.lane + 2] = x.z; T[kk * 257 + 4 * F.lane + 3] = x.w; }
    __syncthreads();
    const int c = F.lane & 7;
#pragma unroll
    for (int j = 0; j < 4; ++j) { const int n = 32 * F.wave + 8 * j + (F.lane >> 3); const LAS float* s = T + (8 * c) * 257 + n;
        v4u o; o.x = pk2(s[0 * 257], s[1 * 257]); o.y = pk2(s[2 * 257], s[3 * 257]); o.z = pk2(s[4 * 257], s[5 * 257]); o.w = pk2(s[6 * 257], s[7 * 257]);
        *(GAS v4u*)(WT + (size_t)(n0 + n) * K + k0 + 8 * c) = o; }
    __syncthreads();
}
__device__ __forceinline__ void rms_rows4_to_bf16(int lane, const float* x0, bf16* o0, size_t stride) {
    f32x4 v[4][4];
#pragma unroll
    for (int r = 0; r < 4; ++r) { const GAS f32x4* xr = (const GAS f32x4*)(x0 + r * stride) + lane;
#pragma unroll
        for (int j = 0; j < 4; ++j) v[r][j] = __builtin_nontemporal_load(&xr[64 * j]); }
#pragma unroll
    for (int r = 0; r < 4; ++r) { float s = 0.f;
#pragma unroll
        for (int j = 0; j < 4; ++j) s += (v[r][j].x * v[r][j].x + v[r][j].y * v[r][j].y) + (v[r][j].z * v[r][j].z + v[r][j].w * v[r][j].w);
        const float rs = rsqrtf(wave_sum(s) * (1.f / DM) + EPS);
        GAS unsigned long long* o8 = (GAS unsigned long long*)(o0 + r * stride) + lane;
#pragma unroll
        for (int j = 0; j < 4; ++j) o8[64 * j] = (unsigned long long)pk2(v[r][j].x * rs, v[r][j].y * rs) | ((unsigned long long)pk2(v[r][j].z * rs, v[r][j].w * rs) << 32); }
}

template <int NBLK>
__device__ __forceinline__ void p0_meta_task(Frame& F, const Ptrs& P, int task) {
    LAS float* xn = (LAS float*)(F.lds + RING_OFF);
    LAS float* part = (LAS float*)(F.lds + RING_OFF + 65536);
    for (int r = F.wave * 2; r < F.wave * 2 + 2; ++r) {
        float v[16]; float s = 0.f;
#pragma unroll
        for (int j = 0; j < 16; ++j) { v[j] = P.meta[(size_t)r * DM + j * 64 + F.lane]; s += v[j] * v[j]; }
        const float rs = rsqrtf(wave_sum(s) * (1.f / DM) + EPS);
#pragma unroll
        for (int j = 0; j < 16; ++j) xn[r * DM + j * 64 + F.lane] = v[j] * rs * P.norm_g[j * 64 + F.lane];
    }
    __syncthreads();
    const int type = task >> 3, g = task & 7;
    const int c0 = type == 0 ? 512 + 64 * g : type == 1 ? 1024 + 64 * g : 2048 + 512 + 64 * g;
    const int c1 = 2048 + 1024 + 64 * g;
    f32x4 acc[8];
#pragma unroll
    for (int i = 0; i < 8; ++i) acc[i] = (f32x4){0.f, 0.f, 0.f, 0.f};
    const int fr = F.lane & 15, fk = F.lane >> 4;
    for (int kc = 0; kc < 4; ++kc) {
        float bv[8][NBLK];
#pragma unroll
        for (int s = 0; s < 8; ++s) { const int k = F.wave * 128 + (kc * 8 + s) * 4 + fk;
#pragma unroll
            for (int blk = 0; blk < NBLK; ++blk) bv[s][blk] = P.w_in[(size_t)k * INC + (blk < 4 ? c0 + 16 * blk : c1 + 16 * (blk - 4)) + fr]; }
        asm volatile("" ::: "memory");
#pragma unroll
        for (int s = 0; s < 8; ++s) { const float a = xn[fr * DM + F.wave * 128 + (kc * 8 + s) * 4 + fk];
#pragma unroll
            for (int blk = 0; blk < NBLK; ++blk) acc[blk] = __builtin_amdgcn_mfma_f32_16x16x4f32(a, bv[s][blk], acc[blk], 0, 0, 0); }
    }
#pragma unroll
    for (int blk = 0; blk < 8; ++blk)
#pragma unroll
        for (int reg = 0; reg < 4; ++reg) part[(F.wave * 16 + 4 * fk + reg) * 128 + 16 * blk + fr] = acc[blk][reg];
    __syncthreads();
    bf16* KI = (bf16*)(P.ws + WS_K); bf16* VI = (bf16*)(P.ws + WS_V); bf16* U = (bf16*)(P.ws + WS_U);
    for (int r = F.wave * 2; r < F.wave * 2 + 2; ++r) {
        float v0 = 0.f, v1 = 0.f;
#pragma unroll
        for (int w = 0; w < 8; ++w) { v0 += part[(w * 16 + r) * 128 + F.lane]; v1 += part[(w * 16 + r) * 128 + 64 + F.lane]; }
        if (type == 0) {
            const float ss = wave_sum(v0 * v0);
            const unsigned short o = (unsigned short)f2bf(v0 * rsqrtf(ss * (1.f / 64.f) + EPS) * P.k_norm_g[F.lane]);
            for (int b = 0; b < BATCH; ++b) KI[kimg_off(b, g >> 1, g & 1, r, F.lane)] = o;
        } else if (type == 1) {
            const unsigned short o = (unsigned short)f2bf(v0);
            for (int b = 0; b < BATCH; ++b) VI[vimg_off(b, g >> 1, r, (g & 1) * 64 + F.lane)] = o;
        } else {
            const unsigned short o = (unsigned short)f2bf(v0 * v1);
            for (int b = 0; b < BATCH; ++b) U[((size_t)b * LTOK + r) * CW + 64 * g + F.lane] = o;
        }
    }
    __syncthreads();
}

#ifdef PROBE_AMP
#define STAMP(k) do { if (blockIdx.x == 0 && F.tid == 0) { const unsigned long long t_ = rt(); F.MISC[16 + 2 * (k)] = (unsigned)t_; F.MISC[17 + 2 * (k)] = (unsigned)(t_ >> 32); } } while (0)
#else
#define STAMP(k) do { } while (0)
#endif
__device__ __forceinline__ void p0_prologue(Frame& F, const Ptrs& P) {
    if (F.vcu < 16) p0_meta_task<4>(F, P, F.vcu); else if (F.vcu < 24) p0_meta_task<8>(F, P, F.vcu);
    STAMP(6);
    const int gw = F.vcu * NWAVES + F.wave, NGW = F.G * NWAVES;
    bf16* WIN = (bf16*)(P.ws + WS_WIN); bf16* WBR = (bf16*)(P.ws + WS_WBR); bf16* WOUT = (bf16*)(P.ws + WS_WOUT); bf16* XB = (bf16*)(P.ws + WS_XB);
    constexpr int I_IN = (DM / 64) * (INC / 256), I_SQ = (DM / 64) * (DM / 256);
    for (int it = F.vcu; it < I_IN + 2 * I_SQ; it += F.G) {
        int r = it;
        if (r < I_IN) { p0_transpose_wg<true, true>(F, P.w_in, DM, INC, WIN, P.norm_g, r); continue; } r -= I_IN;
        if (r < I_SQ) { p0_transpose_wg<false, false>(F, P.w_branch, DM, DM, WBR, nullptr, r); continue; } r -= I_SQ;
        p0_transpose_wg<false, false>(F, P.w_out, DM, DM, WOUT, nullptr, r);
    }
    STAMP(7);
    for (;;) {
        if (F.tid == 0) F.MISC[12] = __hip_atomic_fetch_add((unsigned*)(P.ws + WS_CTL) + CW_ROWQ, 1u, __ATOMIC_RELAXED, __HIP_MEMORY_SCOPE_AGENT);
        __syncthreads();
        const unsigned c = F.MISC[12];
        __syncthreads();
        if (c >= (unsigned)(MROWS / 32)) break;
        const size_t m0 = (size_t)c * 32 + F.wave * 4;
        rms_rows4_to_bf16(F.lane, P.x + m0 * DM, XB + m0 * DM, (size_t)DM);
    }
    STAMP(8);
    { GAS v4u* KI = (GAS v4u*)(P.ws + WS_K); GAS v4u* VI = (GAS v4u*)(P.ws + WS_V); const v4u z = {0u, 0u, 0u, 0u};
      const int gt = F.vcu * 512 + F.tid, NT_ = F.G * 512;
      for (int i = gt; i < 64 * 512; i += NT_) KI[((size_t)(i >> 9) * NKT + 64) * 512 + (i & 511)] = z;
      for (int i = gt; i < 32 * 1024; i += NT_) VI[((size_t)(i >> 10) * NKT + 64) * 1024 + (i & 1023)] = z; }
}

__device__ __forceinline__ void conv_fixup(Frame& F, const Ptrs& P) {
    const bf16* U = (const bf16*)(P.ws + WS_U); const bf16* GB = (const bf16*)(P.ws + WS_GB); bf16* BR = (bf16*)(P.ws + WS_BR);
    const int gw = F.vcu * NWAVES + F.wave, NGW = F.G * NWAVES, ch0 = F.lane * 8;
    const f32x4 w0a = *(const f32x4*)(P.conv_w + ch0), w0b = *(const f32x4*)(P.conv_w + ch0 + 4);
    const f32x4 w1a = *(const f32x4*)(P.conv_w + CW + ch0), w1b = *(const f32x4*)(P.conv_w + CW + ch0 + 4);
    const f32x4 w2a = *(const f32x4*)(P.conv_w + 2 * CW + ch0), w2b = *(const f32x4*)(P.conv_w + 2 * CW + ch0 + 4);
    for (int it = gw; it < MROWS / 32; it += NGW) {
        const int m = (it >> 1) * 64 + (it & 1), b = m / SEQ, s = m % SEQ; const size_t ur = (size_t)b * LTOK + s + NMETA;
        const v4u um2 = *(const GAS v4u*)(U + (ur - 2) * CW + ch0), um1 = *(const GAS v4u*)(U + (ur - 1) * CW + ch0), u0 = *(const GAS v4u*)(U + ur * CW + ch0), gb = *(const GAS v4u*)(GB + (size_t)m * CW + ch0);
        v4u o;
#define CONV2(W, k0_, wa, wb, wc) { const float ylo = wa[k0_] * bflo_(um2.W) + wb[k0_] * bflo_(um1.W) + wc[k0_] * bflo_(u0.W); \
                                    const float yhi = wa[k0_ + 1] * bfhi_(um2.W) + wb[k0_ + 1] * bfhi_(um1.W) + wc[k0_ + 1] * bfhi_(u0.W); \
                                    o.W = pk2(bflo_(gb.W) * ylo, bfhi_(gb.W) * yhi); }
        CONV2(x, 0, w0a, w1a, w2a) CONV2(y, 2, w0a, w1a, w2a) CONV2(z, 0, w0b, w1b, w2b) CONV2(w, 2, w0b, w1b, w2b)
#undef CONV2
        *(GAS v4u*)(BR + (size_t)m * 1024 + 512 + ch0) = o;
    }
}

__device__ __forceinline__ dattn::BlockRef mk_block(const Ptrs& P, int vcu, int i) {
    const int bh = vcu >> 3, j = vcu & 7, b = bh >> 2, h = bh & 3, qb = (i < 2) ? j : 15 - j, c = i & 1; dattn::BlockRef r;
    r.Q = (const bf16*)(P.ws + WS_Q) + ((size_t)b * SEQ + (size_t)qb * 256) * AW + (h * 2 + c) * 64;
    r.K = (const bf16*)(P.ws + WS_K) + (size_t)((b * NH + h) * 2 + c) * NKT * 4096;
    r.V = (const bf16*)(P.ws + WS_V) + (size_t)(b * NH + h) * NKT * 8192;
    r.P0 = NMETA + qb * 256; r.c = c; r.m0 = b * SEQ + qb * 256; r.h = h; return r;
}

struct Args { Ptrs P; int ph_lo, ph_hi, li, pad; };
__global__ void __launch_bounds__(NWAVES * 64, 2) mega_fwd(Args args) {
    extern __shared__ __attribute__((aligned(16))) unsigned char lds[];
    const Ptrs& P = args.P;
    Frame F;
    F.lds = (LAS unsigned char*)lds;
    F.MISC = (volatile LAS unsigned*)(F.lds + MISC_OFF);
    F.tid = threadIdx.x; F.lane = F.tid & 63; F.wave = __builtin_amdgcn_readfirstlane(F.tid >> 6);
    F.G = gridDim.x; { const int bx = blockIdx.x; F.vcu = (F.G % 8 == 0) ? (bx % 8) * (F.G / 8) + bx / 8 : bx; }
    gu32* ctl = (gu32*)(P.ws + WS_CTL);
    for (int u = F.tid; u < (LDS_BYTES - LDSCTL_OFF) / 4; u += NWAVES * 64) ((LAS unsigned*)(F.lds + LDSCTL_OFF))[u] = 0u;
    __syncthreads();
    XcdBarrier bar = xcd_barrier_post((unsigned*)(ctl + CW_BAR) + args.li * XCD_BAR_WORDS, F.MISC + 8);
    const int lo = args.ph_lo, hi = args.ph_hi;
#ifndef PH_COMPILED
#define PH_COMPILED 0x1F
#endif
#define IN(k) (((PH_COMPILED >> (k)) & 1) && lo <= (k) && (k) < hi)
#define BOTH(k) (IN(k) && IN((k) + 1))
    STAMP(0);
    if (IN(0)) { p0_prologue(F, P); if (BOTH(0)) xcd_barrier(bar); }
    STAMP(1);
    if (IN(1)) {
        pg8::Gemm g{(const bf16*)(P.ws + WS_XB), (const bf16*)(P.ws + WS_WIN), MROWS, INC, DM}; pg8::StaticOrder S; S.init(MROWS, INC, F.G, (int)blockIdx.x);
        pg8::EpiProj E{(bf16*)(P.ws + WS_Q), (bf16*)(P.ws + WS_K), (bf16*)(P.ws + WS_V), (bf16*)(P.ws + WS_SG), (bf16*)(P.ws + WS_U), (bf16*)(P.ws + WS_GB), (bf16*)(P.ws + WS_GATE), (bf16*)(P.ws + WS_GATE + 64 * MiB), (bf16*)(P.ws + WS_BR), P.q_norm_g, P.k_norm_g, P.conv_w};
        pg8::gemm_phase<pg8::EpiProj, pg8::StaticOrder, true, true>(F.lds + RING_OFF, g, S, E);
        if (BOTH(1)) xcd_barrier(bar);
    }
    STAMP(2);
    if (IN(2)) {
        conv_fixup(F, P);
        STAMP(9);
#ifdef PROBE_CLK
        if (blockIdx.x == 0 && F.tid == 0) { const unsigned long long c_ = __builtin_amdgcn_s_memtime(); F.MISC[60] = (unsigned)c_; F.MISC[61] = (unsigned)(c_ >> 32); }
#endif
        if (F.G == 256) {
            char* al = (char*)lds + RING_OFF;
            float gq = fabsf(P.q_norm_g[F.lane]), gk = fabsf(P.k_norm_g[F.lane]), gb = fmaxf(fmaxf(fabsf(P.rel_bias[F.lane]), fabsf(P.rel_bias[64 + F.lane])), fmaxf(fabsf(P.rel_bias[128 + F.lane]), fabsf(P.rel_bias[192 + F.lane])));
            gq = wave_max(gq); gk = wave_max(gk); gb = wave_max(gb);
            const float bound = 64.f * C2 * gq * gk + 2.f * LOG2E * gb, shift = bound > 100.f ? bound : 0.f;
            dattn::Outs OU{(const bf16*)(P.ws + WS_SG), (bf16*)(P.ws + WS_BR), P.subln_g, compute_lam(P, F.lane)};
            dattn::Seam S; dattn::BlockRef cur = mk_block(P, F.vcu, 0);
#ifdef PROBE_WAITCYC
            S.wcyc = 0ull;
#endif
            _Pragma("unroll 1") for (int i = 0; i < 4; ++i) {
                if ((i & 1) == 0) {
                    __syncthreads();
                    if (F.tid == 0) *(float*)(al + dattn::L_MISC) = shift;
                    for (int e = F.tid; e < 1024; e += NWAVES * 64) { const int c = e >> 9, jj = e & 511, d = jj - dattn::TAB_OFF;
                        const int dd = d > 113 ? 113 : d;
                        ((float*)(al + dattn::L_TAB))[e] = d < 0 ? -__builtin_inff() : (P.rel_bias[(t5_bucket(dd) * NH + cur.h) * 2 + c] - P.rel_bias[(31 * NH + cur.h) * 2 + c]) * LOG2E - shift; }
                    __syncthreads();
                    if (i == 0) dattn::dattn_issue(cur, al, S);
                }
                const dattn::BlockRef nxt = mk_block(P, F.vcu, i < 3 ? i + 1 : 3); dattn::dattn_block<0>(cur, nxt, i < 3, al, S, OU); cur = nxt; }
            __syncthreads();
#ifdef PROBE_WAITCYC
            if (blockIdx.x == 0 && F.tid == 0) { F.MISC[58] = (unsigned)S.wcyc; F.MISC[59] = (unsigned)(S.wcyc >> 32); }
#endif
        }
        if (BOTH(2)) xcd_barrier(bar);
    }
#ifdef PROBE_CLK
    if (blockIdx.x == 0 && F.tid == 0) { const unsigned long long c_ = __builtin_amdgcn_s_memtime(); F.MISC[62] = (unsigned)c_; F.MISC[63] = (unsigned)(c_ >> 32); }
#endif
    STAMP(3);
    if (IN(3)) {
        pg8::Gemm g{(const bf16*)(P.ws + WS_BR), (const bf16*)(P.ws + WS_WBR), MROWS, DM, DM}; pg8::StaticOrder S; S.init(MROWS, DM, F.G, (int)blockIdx.x);
        pg8::EpiMerge E{(const bf16*)(P.ws + WS_GATE), (const bf16*)(P.ws + WS_GATE + 64 * MiB), (bf16*)(P.ws + WS_MERGED)
#ifdef PROBE_P3CYC
            , (unsigned long long*)(P.ws + WS_CTL + 1024)
#endif
        };
        pg8::gemm_phase<pg8::EpiMerge, pg8::StaticOrder, true, true>(F.lds + RING_OFF, g, S, E);
        if (BOTH(3)) xcd_barrier(bar);
    }
    STAMP(4);
    if (IN(4)) {
        pg8::Gemm g{(const bf16*)(P.ws + WS_MERGED), (const bf16*)(P.ws + WS_WOUT), MROWS, DM, DM}; pg8::StaticOrder S; S.init(MROWS, DM, F.G, (int)blockIdx.x);
        pg8::EpiOut E{P.x, P.out};
        pg8::gemm_phase<pg8::EpiOut, pg8::StaticOrder, true, true>(F.lds + RING_OFF, g, S, E);
    }
    STAMP(5);
#ifdef PROBE_AMP
    if (blockIdx.x == 0 && F.tid == 0) { LDS_WAIT();
        const unsigned long long ta = ((unsigned long long)F.MISC[17 + 2 * PROBE_AMP] << 32) | F.MISC[16 + 2 * PROBE_AMP], tb = ((unsigned long long)F.MISC[17 + 2 * PROBE_AMP_B] << 32) | F.MISC[16 + 2 * PROBE_AMP_B];
#if defined(PROBE_P3CYC)
        const unsigned long long wc_ = *(volatile unsigned long long*)(P.ws + WS_CTL + 1024);
        const unsigned long long tc0_ = __builtin_amdgcn_s_memtime(); while (__builtin_amdgcn_s_memtime() - tc0_ < 9ull * wc_) __builtin_amdgcn_s_sleep(16);
        const unsigned long long target = rt();
#elif defined(PROBE_WAITCYC)
        const unsigned long long wc_ = ((unsigned long long)F.MISC[59] << 32) | F.MISC[58];
        const unsigned long long tc0_ = __builtin_amdgcn_s_memtime(); while (__builtin_amdgcn_s_memtime() - tc0_ < 9ull * wc_) __builtin_amdgcn_s_sleep(16);
        const unsigned long long target = rt();
#elif defined(PROBE_CLK)
        const unsigned long long c0_ = ((unsigned long long)F.MISC[61] << 32) | F.MISC[60], c1_ = ((unsigned long long)F.MISC[63] << 32) | F.MISC[62];
        const unsigned long long target = rt() + (c1_ - c0_) * 1000ull / (tb - ta);
#else
        const unsigned long long target = rt() + 9ull * (tb - ta);
#endif
        while (rt() < target) __builtin_amdgcn_s_sleep(16); }
#endif
#undef IN
#undef BOTH
}

extern "C" void kernel_launch(void* const* d_in, const int* in_sizes, int n_in, void* d_out, int out_size, void* d_ws, size_t ws_size, hipStream_t stream) {
    static int grid = 0;
    if (grid == 0) {
        if (n_in != 15 || out_size != MROWS * DM || ws_size < WS_END) { fprintf(stderr, "kernel_launch: unexpected shapes n_in %d out %d ws %zu\n", n_in, out_size, ws_size); grid = -1; return; }
        int dev = 0, cus = 0;
        if (hipGetDevice(&dev) != hipSuccess || hipDeviceGetAttribute(&cus, hipDeviceAttributeMultiprocessorCount, dev) != hipSuccess) { grid = -1; return; }
        if (hipFuncSetAttribute((const void*)mega_fwd, hipFuncAttributeMaxDynamicSharedMemorySize, LDS_BYTES) != hipSuccess) { fprintf(stderr, "kernel_launch: hipFuncSetAttribute failed\n"); grid = -1; return; }
        if (cus < 256) { fprintf(stderr, "kernel_launch: needs 256 CUs, device has %d\n", cus); grid = -1; return; }
        grid = 256;
    }
    if (grid < 0) return;
    Ptrs P{};
    P.x = (const float*)d_in[0]; P.meta = (const float*)d_in[1]; P.rel_bias = (const float*)d_in[2]; P.norm_g = (const float*)d_in[3]; P.w_in = (const float*)d_in[4];
    P.q_norm_g = (const float*)d_in[5]; P.k_norm_g = (const float*)d_in[6]; P.lq1 = (const float*)d_in[7]; P.lk1 = (const float*)d_in[8]; P.lq2 = (const float*)d_in[9];
    P.lk2 = (const float*)d_in[10]; P.subln_g = (const float*)d_in[11]; P.conv_w = (const float*)d_in[12]; P.w_branch = (const float*)d_in[13]; P.w_out = (const float*)d_in[14];
    P.out = (float*)d_out; P.ws = (unsigned char*)d_ws;
    if (hipMemsetAsync((char*)d_ws + WS_CTL, 0, CTL_ZERO_BYTES, stream) != hipSuccess) { fprintf(stderr, "kernel_launch: memset failed\n"); return; }
    int li = 0;
#ifdef PROBE_TWICE
    const int seq[2][2] = {{0, 5}, {0, 5}}; const int nseq = 2;
#elif defined(PROBE_REPEAT)
    const int seq[2][2] = {{0, PROBE_REPEAT + 1}, {PROBE_REPEAT, 5}}; const int nseq = 2;
#else
    const int seq[1][2] = {{0, 5}}; const int nseq = 1;
#endif
    for (int s = 0; s < nseq; ++s) {
        Args a{}; a.P = P; a.ph_lo = seq[s][0]; a.ph_hi = seq[s][1]; a.li = li++; a.pad = 0;
        hipLaunchKernelGGL(mega_fwd, dim3(grid), dim3(NWAVES * 64), LDS_BYTES, stream, a);
    }
}
```

```cpp
#include <hip/hip_runtime.h>
#include <cstdio>
#include <cstdint>

constexpr int BATCH = 8, SEQ = 4096, DM = 1024, NMETA = 16, LTOK = NMETA + SEQ  , MROWS = BATCH * SEQ  ;
constexpr int NH = 4, HD = 64, VD = 128, AW = 512, CW = 512, INC = 6144;
constexpr int NKT = 66;
constexpr float EPS = 1e-6f;
constexpr float LOG2E = 1.4426950408889634f;
constexpr float C2 = 0.125f * LOG2E;
constexpr float LAM_INIT = 0.2f;

typedef unsigned short bf16_t;
__device__ __forceinline__ float bf2f(unsigned short h) { return __builtin_bit_cast(float, (unsigned)h << 16); }

constexpr size_t MiB = 1u << 20;
constexpr size_t WS_CTL = 0;
constexpr size_t WS_RS = 1 * MiB;
constexpr size_t WS_WIN = 2 * MiB;
constexpr size_t WS_WBR = 14 * MiB;
constexpr size_t WS_WOUT = 16 * MiB;
constexpr size_t WS_XB = 18 * MiB;
constexpr size_t WS_BR = 405 * MiB;
constexpr size_t WS_Q = 82 * MiB;
constexpr size_t WS_K = 114 * MiB;
constexpr size_t WS_MERGED = WS_Q;
constexpr size_t WS_V = 147 * MiB;
constexpr size_t WS_SG = 180 * MiB;
constexpr size_t WS_U = 212 * MiB;
constexpr size_t WS_GB = 245 * MiB;
constexpr size_t WS_GATE = 277 * MiB;
constexpr size_t WS_END = 469 * MiB;

__host__ __device__ __forceinline__ size_t kimg_off(int b, int h, int c, int pos, int d) {
    const int j = pos >> 6, row = pos & 63, chunk = d >> 3;
    const size_t tile = (size_t)((b * NH + h) * 2 + c) * NKT + j;
    return tile * 4096 + row * 64 + ((chunk ^ ((row >> 1) & 7)) << 3) + (d & 7);
}
__host__ __device__ __forceinline__ size_t vimg_off(int b, int h, int pos, int dv) {
    const int j = pos >> 6, k = pos & 63;
    const int kk = (k & ~0xC) | ((k & 4) << 1) | ((k & 8) >> 1);
    const size_t tile = (size_t)(b * NH + h) * NKT + j;
    return tile * 8192 + ((kk >> 3) * 4 + (dv >> 5)) * 256 + (kk & 7) * 32 + (dv & 31);
}
__device__ __forceinline__ int t5_bucket(int d) {
    if (d < 16) return d;
    int b = 16;
    b += (d >= 19); b += (d >= 21); b += (d >= 24); b += (d >= 27); b += (d >= 31); b += (d >= 35); b += (d >= 40); b += (d >= 46);
    b += (d >= 52); b += (d >= 59); b += (d >= 67); b += (d >= 77); b += (d >= 87); b += (d >= 99); b += (d >= 113);
    return b;
}
__device__ __forceinline__ float wave_sum(float v) {
#pragma unroll
    for (int o = 1; o < 64; o <<= 1) v += __shfl_xor(v, o);
    return v;
}
__device__ __forceinline__ float wave_max(float v) {
#pragma unroll
    for (int o = 1; o < 64; o <<= 1) v = fmaxf(v, __shfl_xor(v, o));
    return v;
}
__device__ __forceinline__ float silu_f(float v) { return v / (1.f + __expf(-v)); }
__device__ __forceinline__ float sigmoid_f(float v) { return 1.f / (1.f + __expf(-v)); }

struct Ptrs {
    const float *x, *meta, *rel_bias, *norm_g, *w_in, *q_norm_g, *k_norm_g, *lq1, *lk1, *lq2, *lk2, *subln_g, *conv_w, *w_branch, *w_out;
    float* out; unsigned char* ws;
};

#define GAS __attribute__((address_space(1)))
#define LAS __attribute__((address_space(3)))
typedef unsigned short bf16;
typedef unsigned v4u __attribute__((ext_vector_type(4)));
typedef float f32x4 __attribute__((ext_vector_type(4)));
typedef short bf16x8 __attribute__((ext_vector_type(8)));
typedef GAS unsigned gu32;
typedef GAS unsigned long long gu64;
#define RLX_AGENT __ATOMIC_RELAXED, __HIP_MEMORY_SCOPE_AGENT
#define LDS_WAIT() asm volatile("s_waitcnt lgkmcnt(0)" ::: "memory")
#define VM_WAIT() asm volatile("s_waitcnt vmcnt(0)" ::: "memory")
__device__ __forceinline__ unsigned long long rt() { return __builtin_amdgcn_s_memrealtime(); }
__device__ __forceinline__ unsigned f2bf(float f) { unsigned u = __builtin_bit_cast(unsigned, f); return (u + 0x7fffu + ((u >> 16) & 1u)) >> 16; }
__device__ __forceinline__ unsigned pk2(float lo, float hi) { return f2bf(lo) | (f2bf(hi) << 16); }

__device__ __forceinline__ float compute_lam(const Ptrs& P, int lane) {
    const float a = wave_sum(P.lq1[lane] * P.lk1[lane]), c = wave_sum(P.lq2[lane] * P.lk2[lane]);
    return __expf(a) - __expf(c) + LAM_INIT;
}
__device__ __forceinline__ float bflo_(unsigned w) { return __builtin_bit_cast(float, w << 16); }
__device__ __forceinline__ float bfhi_(unsigned w) { return __builtin_bit_cast(float, w & 0xffff0000u); }

#define XB_TMO      128
#define XB_XCNT(j)  (256  + 64 * (j))
#define XB_XSUB(j)  (1280 + 64 * (j))
#define XB_XGEN(j)  (2304 + 64 * (j))
#define XB_TOP      3328
#define XB_TOPGEN   3392
#define XCD_BAR_WORDS 3456
#define XB_SPIN_CAP (1u << 18)

__device__ __forceinline__ unsigned xb_ld(unsigned* p)              { return __hip_atomic_load(p, __ATOMIC_RELAXED, __HIP_MEMORY_SCOPE_AGENT); }
__device__ __forceinline__ unsigned xb_add(unsigned* p, unsigned v) { return __hip_atomic_fetch_add(p, v, __ATOMIC_RELAXED, __HIP_MEMORY_SCOPE_AGENT); }
__device__ __forceinline__ unsigned xb_xcc_id() { return (unsigned)__builtin_amdgcn_s_getreg((3 << 11) | 20) & 0xFu; }
#define XB_SPIN(cond, bar) do { unsigned _sp = 0; while (cond) { __builtin_amdgcn_s_sleep(1); \
    if ((++_sp & 255u) == 0u) { if (xb_ld(&(bar)[XB_TMO])) break; if (_sp > XB_SPIN_CAP) { atomicAdd(&(bar)[XB_TMO], 1u); break; } } } } while (0)

struct XcdBarrier {
    unsigned* bar; unsigned x;
    volatile LAS unsigned* st;
};

__device__ __forceinline__ XcdBarrier xcd_barrier_post(unsigned* bar, volatile LAS unsigned* st) {
    XcdBarrier b; b.bar = bar; b.x = xb_xcc_id(); b.st = st;
    if (threadIdx.x == 0) (void)xb_add(&bar[XB_XCNT(b.x)], 1u);
    return b;
}
__device__ __forceinline__ void xcd_barrier_complete(unsigned* bar, unsigned x, unsigned& nloc, unsigned& nx) {
    const unsigned G = gridDim.x * gridDim.y * gridDim.z;
    unsigned sum, cnt, mine, sp = 0u;
    for (;;) {
        sum = 0u; cnt = 0u; mine = 0u;
#pragma unroll
        for (unsigned j = 0; j < 16; ++j) { const unsigned c = xb_ld(&bar[XB_XCNT(j)]); sum += c; cnt += (c > 0u) ? 1u : 0u; mine = (j == x) ? c : mine; }
        if (sum == G) break;
        __builtin_amdgcn_s_sleep(1);
        if ((++sp & 255u) == 0u) { if (xb_ld(&bar[XB_TMO])) break; if (sp > XB_SPIN_CAP) { atomicAdd(&bar[XB_TMO], 1u); break; } }
    }
    nloc = mine > 0u ? mine : 1u; nx = cnt > 0u ? cnt : 1u;
}

__device__ __forceinline__ void xcd_barrier(const XcdBarrier& b) {
    asm volatile("s_waitcnt vmcnt(0)" ::: "memory");
    __syncthreads();
    if (threadIdx.x == 0) {
        unsigned* bar = b.bar;
        __builtin_amdgcn_s_waitcnt(0);
        unsigned nloc = b.st[0], nx = b.st[1];
        if (nloc == 0u) { xcd_barrier_complete(bar, b.x, nloc, nx); b.st[0] = nloc; b.st[1] = nx; }
        const unsigned old = xb_add(&bar[XB_XSUB(b.x)], 1u);
        const unsigned gen = old / nloc;
        if (old + 1u == (gen + 1u) * nloc) {
            __builtin_amdgcn_fence(__ATOMIC_RELEASE, "agent");
            asm volatile("s_waitcnt vmcnt(0)" ::: "memory");
            const unsigned og = xb_add(&bar[XB_TOP], 1u);
            const unsigned tg = og / nx;
            if (og + 1u == (tg + 1u) * nx) xb_add(&bar[XB_TOPGEN], 1u);
            else XB_SPIN(xb_ld(&bar[XB_TOPGEN]) == tg, bar);
            __builtin_amdgcn_fence(__ATOMIC_ACQUIRE, "agent");
            xb_add(&bar[XB_XGEN(b.x)], 1u);
            asm volatile("s_waitcnt vmcnt(0)" ::: "memory");
        } else {
            XB_SPIN(xb_ld(&bar[XB_XGEN(b.x)]) == gen, bar);
            __builtin_amdgcn_fence(__ATOMIC_ACQUIRE, "agent");
            asm volatile("s_waitcnt vmcnt(0)" ::: "memory");
        }
    }
    __syncthreads();
}

namespace pg8 {
#define PG8_LAS __attribute__((address_space(3)))
typedef unsigned short bf16_t;
typedef short bf16x8 __attribute__((ext_vector_type(8)));
typedef float f32x4 __attribute__((ext_vector_type(4)));
typedef unsigned u32x4 __attribute__((ext_vector_type(4)));
constexpr int BM = 256, BK = 64, HALF = 128, HTB = HALF * BK * 2  , STAGE_BYTES = 8 * HTB, NXCD = 8, WGM = 8;

__host__ __device__ __forceinline__ int lds_byte(int r, int c) { const int st = (r >> 4) * 2 + (c >> 5), rr = r & 15, cc = c & 31, ob = rr * 64 + cc * 2; return st * 1024 + (ob ^ (((ob >> 9) & 1) << 5)); }
__host__ __device__ __forceinline__ void stage_rc(int b, int& R, int& C) { const int st = b / 1024, sb = b % 1024, swz = sb ^ (((sb >> 9) & 1) << 5); R = (st >> 1) * 16 + swz / 64; C = (st & 1) * 32 + (swz % 64) / 2; }
__host__ __device__ __forceinline__ int perm32(int rho) { const int n = rho >> 4, i = rho & 15; return 8 * (i >> 2) + 4 * n + (i & 3); }

struct Unit { int pm, pn; };
struct Gemm { const bf16_t* A; const bf16_t* Bt; int M, N, K; };

struct StaticOrder {
    int nM, nN, nwg, G, c;
    __host__ __device__ void init(int M, int N, int G_, int c_) { nM = M / BM; nN = N / BM; nwg = nM * nN; G = G_; c = c_; }
    __host__ __device__ bool next(int i, Unit& u) const {
        const long L = (long)i * G + c; if (L >= nwg) return false;
        int wgid = (int)L; { const int q = nwg / NXCD, r = nwg % NXCD, xcd = wgid % NXCD, off = wgid / NXCD; wgid = (xcd < r ? xcd * (q + 1) : r * (q + 1) + (xcd - r) * q) + off; }
        const int nig = WGM * nN, gid = wgid / nig, fm = gid * WGM, gsz = (nM - fm) < WGM ? (nM - fm) : WGM;
        u.pm = fm + ((wgid % nig) % gsz); u.pn = (wgid % nig) / gsz; return true;
    }
    __device__ __forceinline__ void a_ready(const Unit&) const {}
    __device__ __forceinline__ void done(const Unit&) const {}
};

typedef float f32x2_t __attribute__((ext_vector_type(2))); typedef __bf16 bf16x2_t __attribute__((ext_vector_type(2)));
__device__ __forceinline__ unsigned cvt_pk_bf16(float lo, float hi) { f32x2_t v = {lo, hi}; bf16x2_t b = __builtin_convertvector(v, bf16x2_t); return __builtin_bit_cast(unsigned, b); }
__device__ __forceinline__ float fast_sigmoid(float v) { return __builtin_amdgcn_rcpf(1.f + __builtin_amdgcn_exp2f(-1.4426950408889634f * v)); }
__device__ __forceinline__ float fast_silu(float v) { return v * fast_sigmoid(v); }
__device__ __forceinline__ u32x4 pack8f(const f32x4 a, const f32x4 b) { u32x4 w; w.x = cvt_pk_bf16(a[0], a[1]); w.y = cvt_pk_bf16(a[2], a[3]); w.z = cvt_pk_bf16(b[0], b[1]); w.w = cvt_pk_bf16(b[2], b[3]); return w; }
__device__ __forceinline__ float bflo(unsigned w) { return __builtin_bit_cast(float, w << 16); }
__device__ __forceinline__ float bfhi(unsigned w) { return __builtin_bit_cast(float, w & 0xffff0000u); }

struct EpiProj {
    static constexpr bool PERM = true, AFTER_DRAIN = false, HAS_MID = false, HAS_INIT = false;
    bf16_t *Q, *KI, *VI, *SG, *U, *GB, *RT, *G1, *BRc; const float *qg, *kg, *cw;
    __device__ __forceinline__ void mid(f32x4 (&)[2][2][4][2], const Unit&, int, int, int, int) const {}
    __device__ __forceinline__ void operator()(f32x4 (&acc)[2][2][4][2], const Unit& u, int wr, int wc, int fr, int fq) const {
        const int b = u.pm >> 4, s0 = (u.pm & 15) * 256, pn = u.pn; int rl0 = wr * 64 + fr; asm volatile("" : "+v"(rl0)); asm volatile("" : "+v"(fq));
        if (pn < 4) {
            const bool isq = pn < 2; const float* gp = isq ? qg : kg;
            f32x4 gv[2][2];
#pragma unroll
            for (int bj = 0; bj < 2; ++bj)
#pragma unroll
                for (int n = 0; n < 2; ++n) gv[bj][n] = *(const f32x4*)(gp + 32 * bj + 8 * fq + 4 * n);
            const int grp = (pn & 1) * 4 + wc;
#pragma unroll
            for (int ai = 0; ai < 2; ++ai)
#pragma unroll
                for (int m = 0; m < 4; ++m) {
                    float ss = 0.f;
#pragma unroll
                    for (int bj = 0; bj < 2; ++bj)
#pragma unroll
                        for (int n = 0; n < 2; ++n) { const f32x4 x = acc[ai][bj][m][n]; ss += (x[0] * x[0] + x[1] * x[1]) + (x[2] * x[2] + x[3] * x[3]); }
                    ss += __shfl_xor(ss, 16); ss += __shfl_xor(ss, 32);
                    const float sc = rsqrtf(ss * (1.f / 64.f) + EPS) * (isq ? C2 : 1.f);
                    const int rl = rl0 + 128 * ai + 16 * m;
#pragma unroll
                    for (int bj = 0; bj < 2; ++bj) {
                        const u32x4 w = pack8f(acc[ai][bj][m][0] * sc * gv[bj][0], acc[ai][bj][m][1] * sc * gv[bj][1]);
                        if (isq) *(u32x4*)(Q + (size_t)(u.pm * 256 + rl) * AW + grp * 64 + 32 * bj + 8 * fq) = w;
                        else *(u32x4*)(KI + kimg_off(b, grp >> 1, grp & 1, s0 + rl + NMETA, 32 * bj + 8 * fq)) = w;
                    }
                }
        } else if (pn < 6) {
#pragma unroll
            for (int ai = 0; ai < 2; ++ai)
#pragma unroll
                for (int m = 0; m < 4; ++m) { const int rl = rl0 + 128 * ai + 16 * m;
#pragma unroll
                    for (int bj = 0; bj < 2; ++bj)
                        *(u32x4*)(VI + vimg_off(b, (pn - 4) * 2 + bj, s0 + rl + NMETA, 32 * wc + 8 * fq)) = pack8f(acc[ai][bj][m][0], acc[ai][bj][m][1]);
                }
        } else if (pn < 8) {
#pragma unroll
            for (int ai = 0; ai < 2; ++ai)
#pragma unroll
                for (int m = 0; m < 4; ++m) { const int rl = rl0 + 128 * ai + 16 * m;
#pragma unroll
                    for (int bj = 0; bj < 2; ++bj) { f32x4 a = acc[ai][bj][m][0], c = acc[ai][bj][m][1];
#pragma unroll
                        for (int i = 0; i < 4; ++i) { a[i] = fast_silu(a[i]); c[i] = fast_silu(c[i]); }
                        *(u32x4*)(SG + (size_t)(u.pm * 256 + rl) * AW + (pn - 6) * 256 + 128 * bj + 32 * wc + 8 * fq) = pack8f(a, c); }
                }
        } else if (pn < 16) {
            const int ch0 = 64 * (pn - 8) + 16 * wc + 4 * fq;
            const f32x4 w0 = *(const f32x4*)(cw + ch0), w1 = *(const f32x4*)(cw + CW + ch0), w2 = *(const f32x4*)(cw + 2 * CW + ch0);
#pragma unroll
            for (int ai = 0; ai < 2; ++ai) {
                f32x4 uu[4];
#pragma unroll
                for (int m = 0; m < 4; ++m) uu[m] = acc[ai][0][m][0] * acc[ai][0][m][1];
#pragma unroll
                for (int m = 0; m < 4; ++m) { const int rl = rl0 + 128 * ai + 16 * m;
                    f32x4 g = acc[ai][1][m][1];
#pragma unroll
                    for (int i = 0; i < 4; ++i) g[i] = fast_silu(g[i]);
                    const f32x4 gb = acc[ai][1][m][0] * g;
                    f32x4 u1, u2;
#pragma unroll
                    for (int i = 0; i < 4; ++i) {
                        const float pv_ = uu[m > 0 ? m - 1 : 0][i], cu_ = uu[m][i];
                        const int ln = threadIdx.x & 63;
                        const float a1 = __shfl(cu_, ln - 1), b1 = __shfl(pv_, ln + 15), a2 = __shfl(cu_, ln - 2), b2 = __shfl(pv_, ln + 14);
                        u1[i] = fr >= 1 ? a1 : b1; u2[i] = fr >= 2 ? a2 : b2;
                    }
                    const f32x4 cv = gb * (w0 * u2 + w1 * u1 + w2 * uu[m]);
                    const int r64 = 16 * m + fr;
                    if (r64 >= 2) { uint2 wc_; wc_.x = cvt_pk_bf16(cv[0], cv[1]); wc_.y = cvt_pk_bf16(cv[2], cv[3]); typedef unsigned u32x2_t __attribute__((ext_vector_type(2))); __builtin_nontemporal_store((u32x2_t){wc_.x, wc_.y}, (u32x2_t*)(BRc + (size_t)(u.pm * 256 + rl) * 1024 + 512 + ch0)); }
                    if (r64 < 2 || r64 >= 62) { uint2 wu; wu.x = cvt_pk_bf16(uu[m][0], uu[m][1]); wu.y = cvt_pk_bf16(uu[m][2], uu[m][3]); *(uint2*)(U + ((size_t)b * LTOK + s0 + rl + NMETA) * CW + ch0) = wu; }
                    if (r64 < 2) { uint2 wg; wg.x = cvt_pk_bf16(gb[0], gb[1]); wg.y = cvt_pk_bf16(gb[2], gb[3]); *(uint2*)(GB + (size_t)(u.pm * 256 + rl) * CW + ch0) = wg; }
                }
            }
        } else {
            const int j0 = 128 * (pn - 16) + 32 * wc + 8 * fq;
#pragma unroll
            for (int ai = 0; ai < 2; ++ai)
#pragma unroll
                for (int m = 0; m < 4; ++m) { const int rl = rl0 + 128 * ai + 16 * m;
                    f32x4 rt[2], s1[2];
#pragma unroll
                    for (int n = 0; n < 2; ++n)
#pragma unroll
                        for (int i = 0; i < 4; ++i) {
                            const float e0 = __builtin_amdgcn_exp2f(fminf(-1.4426950408889634f * acc[ai][0][m][n][i], 60.f)), e1 = __builtin_amdgcn_exp2f(fminf(-1.4426950408889634f * acc[ai][1][m][n][i], 60.f));
                            rt[n][i] = (1.f + e1) * __builtin_amdgcn_rcpf(1.f + e0); s1[n][i] = __builtin_amdgcn_rcpf(1.f + e1); }
                    __builtin_nontemporal_store(pack8f(rt[0], rt[1]), (u32x4*)(RT + (size_t)(u.pm * 256 + rl) * DM + j0));
                    __builtin_nontemporal_store(pack8f(s1[0], s1[1]), (u32x4*)(G1 + (size_t)(u.pm * 256 + rl) * DM + j0));
                }
        }
    }
};

struct EpiMerge {
    static constexpr bool PERM = true, AFTER_DRAIN = false, HAS_MID = true, HAS_INIT = false;
    const bf16_t* RT; const bf16_t* G1; bf16_t* MG;
#ifdef PROBE_P3CYC
    unsigned long long* wc;
#endif
    __device__ __forceinline__ void scale(f32x4 (&acc)[2][2][4][2], const bf16_t* G, const Unit& u, int wr, int wc, int fr, int fq) const {
        u32x4 gv[2][4][2];
#pragma unroll
        for (int ai = 0; ai < 2; ++ai)
#pragma unroll
            for (int m = 0; m < 4; ++m) { const size_t row = (size_t)u.pm * 256 + 128 * ai + 64 * wr + 16 * m + fr;
#pragma unroll
                for (int bj = 0; bj < 2; ++bj) gv[ai][m][bj] = __builtin_nontemporal_load((const u32x4*)(G + row * DM + u.pn * 256 + 128 * bj + 32 * wc + 8 * fq)); }
#pragma unroll
        for (int ai = 0; ai < 2; ++ai)
#pragma unroll
            for (int m = 0; m < 4; ++m)
#pragma unroll
                for (int bj = 0; bj < 2; ++bj) { const u32x4 a = gv[ai][m][bj];
                    acc[ai][bj][m][0] *= (f32x4){bflo(a.x), bfhi(a.x), bflo(a.y), bfhi(a.y)}; acc[ai][bj][m][1] *= (f32x4){bflo(a.z), bfhi(a.z), bflo(a.w), bfhi(a.w)}; }
    }
    __device__ __forceinline__ void mid(f32x4 (&acc)[2][2][4][2], const Unit& u, int wr, int wc, int fr, int fq) const {
        asm volatile("" : "+v"(fr)); asm volatile("" : "+v"(fq));
#ifdef PROBE_P3CYC
        const unsigned long long t0_ = __builtin_amdgcn_s_memtime();
#endif
        scale(acc, RT, u, wr, wc, fr, fq);
#ifdef PROBE_P3CYC
        asm volatile("" : "+v"(acc[0][0][0][0])); if (blockIdx.x == 0 && threadIdx.x == 0) *this->wc += __builtin_amdgcn_s_memtime() - t0_;
#endif
    }
    __device__ __forceinline__ void operator()(f32x4 (&acc)[2][2][4][2], const Unit& u, int wr, int wc, int fr, int fq) const {
        asm volatile("" : "+v"(fr)); asm volatile("" : "+v"(fq));
        scale(acc, G1, u, wr, wc, fr, fq);
#pragma unroll
        for (int ai = 0; ai < 2; ++ai)
#pragma unroll
            for (int m = 0; m < 4; ++m) { const size_t row = (size_t)u.pm * 256 + 128 * ai + 64 * wr + 16 * m + fr;
#pragma unroll
                for (int bj = 0; bj < 2; ++bj) *(u32x4*)(MG + row * DM + u.pn * 256 + 128 * bj + 32 * wc + 8 * fq) = pack8f(acc[ai][bj][m][0], acc[ai][bj][m][1]); }
    }
};

struct EpiOut {
    static constexpr bool PERM = false, AFTER_DRAIN = false, HAS_MID = false, HAS_INIT = true;
    const float* x; float* out;
    __device__ __forceinline__ void mid(f32x4 (&)[2][2][4][2], const Unit&, int, int, int, int) const {}
    __device__ __forceinline__ void init(f32x4 (&acc)[2][2][4][2], const Unit& u, int wr, int wc, int fr, int fq) const {
        asm volatile("" : "+v"(fr)); asm volatile("" : "+v"(fq));
#pragma unroll
        for (int ai = 0; ai < 2; ++ai)
#pragma unroll
            for (int m = 0; m < 4; ++m) { const size_t off = ((size_t)u.pm * 256 + 128 * ai + 64 * wr + 16 * m + fr) * DM + u.pn * 256 + 32 * wc + 4 * fq;
#pragma unroll
                for (int bj = 0; bj < 2; ++bj)
#pragma unroll
                    for (int n = 0; n < 2; ++n) acc[ai][bj][m][n] = __builtin_nontemporal_load((const f32x4*)(x + off + bj * HALF + n * 16)); }
    }
    __device__ __forceinline__ void operator()(f32x4 (&acc)[2][2][4][2], const Unit& u, int wr, int wc, int fr, int fq) const {
        asm volatile("" : "+v"(fr)); asm volatile("" : "+v"(fq));
#pragma unroll
        for (int ai = 0; ai < 2; ++ai)
#pragma unroll
            for (int m = 0; m < 4; ++m) { const size_t off = ((size_t)u.pm * 256 + 128 * ai + 64 * wr + 16 * m + fr) * DM + u.pn * 256 + 32 * wc + 4 * fq;
#pragma unroll
                for (int bj = 0; bj < 2; ++bj)
#pragma unroll
                    for (int n = 0; n < 2; ++n) *(f32x4*)(out + off + bj * HALF + n * 16) = acc[ai][bj][m][n]; }
    }
};

template <class Epi, class Sched, bool ALIGN_EPI = false, bool SP2 = false>
__device__ __forceinline__ void gemm_phase(PG8_LAS unsigned char* lds, const Gemm g, const Sched& S, const Epi& E) {
    const int tid = threadIdx.x, wid = __builtin_amdgcn_readfirstlane(tid >> 6), lane = tid & 63, wr = wid >> 2, wc = wid & 3, fr = lane & 15, fq = lane >> 4;
    const int K = g.K, nt = K / BK;
    unsigned voffA[2], voffB[2];
#pragma unroll
    for (int i = 0; i < 2; ++i) { int R, C; stage_rc(tid * 16 + i * 8192, R, C); const int Rb = Epi::PERM ? ((R & ~31) + perm32(R & 31)) : R;
        voffA[i] = (unsigned)(R * K + C) * 2u; voffB[i] = (unsigned)(Rb * K + C) * 2u; }
    const size_t kstep = (size_t)(BK * 2);
    const size_t hstep = (size_t)HALF * K * 2;
    const size_t tstep = 2 * hstep;
    const unsigned ldsw = (unsigned)wid * 1024u;
    const int aoff = lds_byte(wr * 64 + fr, fq * 8), boff = lds_byte(wc * 32 + fr, fq * 8);
#define PG8_SA(b, h) (((b) * 2 + (h)) * HTB)
#define PG8_SB(b, h) ((4 + (b) * 2 + (h)) * HTB)
#define PG8_STAGE(bufoff, gbase, voff) do { _Pragma("unroll") for (int _i = 0; _i < 2; ++_i) \
        __builtin_amdgcn_global_load_lds((const unsigned*)((const char*)(gbase) + (voff)[_i]), (PG8_LAS unsigned*)(lds + (bufoff) + ldsw + _i * 8192), 16, 0, 0); } while (0)
#define PG8_LDA(dst, b, h) do { _Pragma("unroll") for (int m = 0; m < 4; ++m) _Pragma("unroll") for (int k = 0; k < 2; ++k) dst[m][k] = *(const PG8_LAS bf16x8*)(lds + PG8_SA(b, h) + aoff + m * 2048 + k * 1024); } while (0)
#define PG8_LDB(dst, b, h) do { _Pragma("unroll") for (int n = 0; n < 2; ++n) _Pragma("unroll") for (int k = 0; k < 2; ++k) dst[n][k] = *(const PG8_LAS bf16x8*)(lds + PG8_SB(b, h) + boff + n * 2048 + k * 1024); } while (0)
#define PG8_MMA(ai, bj, At, Bt) do { __builtin_amdgcn_s_setprio(1); _Pragma("unroll") for (int m = 0; m < 4; ++m) _Pragma("unroll") for (int n = 0; n < 2; ++n) _Pragma("unroll") for (int k = 0; k < 2; ++k) \
        acc[ai][bj][m][n] = __builtin_amdgcn_mfma_f32_16x16x32_bf16(Bt[n][k], At[m][k], acc[ai][bj][m][n], 0, 0, 0); __builtin_amdgcn_s_setprio(0); } while (0)
#define PG8_WAIT_V(n) asm volatile("s_waitcnt vmcnt(" #n ")" ::: "memory")
#define PG8_WAIT_L(n) asm volatile("s_waitcnt lgkmcnt(" #n ")" ::: "memory")
#define PG8_BAR __builtin_amdgcn_s_barrier()
#define PG8_SCHED __builtin_amdgcn_sched_barrier(0)
    Unit cur, nxt; int ui = 0;
    if (!S.next(0, cur)) return;
    f32x4 acc[2][2][4][2];
#pragma unroll
    for (int a = 0; a < 2; ++a)
#pragma unroll
        for (int b = 0; b < 2; ++b)
#pragma unroll
            for (int m = 0; m < 4; ++m)
#pragma unroll
                for (int n = 0; n < 2; ++n) acc[a][b][m][n] = (f32x4){0.f, 0.f, 0.f, 0.f};
    if constexpr (Epi::HAS_INIT) E.init(acc, cur, wr, wc, fr, fq);
    bf16x8 At[4][2], B0[2][2], B1[2][2];
    const char* cA = (const char*)g.A + (size_t)cur.pm * tstep; const char* cB = (const char*)g.Bt + (size_t)cur.pn * tstep;
    S.a_ready(cur);
    if constexpr (SP2) {
        PG8_STAGE(PG8_SB(0, 0), cB, voffB); PG8_STAGE(PG8_SB(0, 1), cB + hstep, voffB); PG8_STAGE(PG8_SA(0, 0), cA, voffA); PG8_STAGE(PG8_SA(0, 1), cA + hstep, voffA);
        if (wr == 1) PG8_BAR;
        PG8_WAIT_V(2); PG8_BAR;
        PG8_STAGE(PG8_SB(1, 0), cB + kstep, voffB); PG8_STAGE(PG8_SA(1, 0), cA + kstep, voffA); PG8_STAGE(PG8_SB(1, 1), cB + hstep + kstep, voffB);
        PG8_WAIT_V(6); PG8_BAR;
    } else {
        PG8_STAGE(PG8_SB(0, 0), cB, voffB); PG8_STAGE(PG8_SA(0, 0), cA, voffA); PG8_STAGE(PG8_SB(0, 1), cB + hstep, voffB); PG8_STAGE(PG8_SA(0, 1), cA + hstep, voffA);
        if (wr == 1) PG8_BAR;
        PG8_WAIT_V(4); PG8_BAR;
        PG8_STAGE(PG8_SB(1, 0), cB + kstep, voffB); PG8_STAGE(PG8_SA(1, 0), cA + kstep, voffA); PG8_STAGE(PG8_SB(1, 1), cB + hstep + kstep, voffB);
        PG8_WAIT_V(6); PG8_BAR;
    }
    for (;;) {
        const bool has_next = S.next(ui + 1, nxt);
        const char* nA = has_next ? (const char*)g.A + (size_t)nxt.pm * tstep : cA; const char* nB = has_next ? (const char*)g.Bt + (size_t)nxt.pn * tstep : cB;
        for (int t = 0; t < nt; t += 2) {
            if constexpr (Epi::HAS_MID) { if (t == nt / 2) E.mid(acc, cur, wr, wc, fr, fq); }
            const bool last = (t == nt - 2);
            const char* a1 = cA + (size_t)(t + 1) * kstep;
            const char* a2 = last ? nA : cA + (size_t)(t + 2) * kstep; const char* b2 = last ? nB : cB + (size_t)(t + 2) * kstep;
            const char* a3 = a2 + kstep; const char* b3 = b2 + kstep;
            if (last && has_next) S.a_ready(nxt);
            if constexpr (SP2) {
            PG8_LDB(B0, 0, 0); PG8_LDB(B1, 0, 1); PG8_SCHED; PG8_LDA(At, 0, 0); PG8_STAGE(PG8_SA(1, 1), a1 + hstep, voffA);
            PG8_WAIT_V(8); PG8_WAIT_L(0); PG8_BAR; PG8_MMA(0, 0, At, B0); PG8_MMA(0, 1, At, B1); PG8_BAR; PG8_SCHED;
            PG8_LDA(At, 0, 1); PG8_STAGE(PG8_SB(0, 0), b2, voffB); PG8_STAGE(PG8_SB(0, 1), b2 + hstep, voffB); PG8_STAGE(PG8_SA(0, 0), a2, voffA);
            PG8_WAIT_V(8); PG8_WAIT_L(0); PG8_BAR; PG8_MMA(1, 0, At, B0); PG8_MMA(1, 1, At, B1); PG8_BAR; PG8_SCHED;
            PG8_LDB(B0, 1, 0); PG8_LDB(B1, 1, 1); PG8_SCHED; PG8_LDA(At, 1, 0); PG8_STAGE(PG8_SA(0, 1), a2 + hstep, voffA);
            PG8_WAIT_V(8); PG8_WAIT_L(0); PG8_BAR; PG8_MMA(0, 0, At, B0); PG8_MMA(0, 1, At, B1); PG8_BAR; PG8_SCHED;
            PG8_LDA(At, 1, 1); PG8_STAGE(PG8_SB(1, 0), b3, voffB); PG8_STAGE(PG8_SB(1, 1), b3 + hstep, voffB); PG8_STAGE(PG8_SA(1, 0), a3, voffA);
            PG8_WAIT_V(8); PG8_WAIT_L(0); PG8_BAR; PG8_MMA(1, 0, At, B0); PG8_MMA(1, 1, At, B1); PG8_BAR; PG8_SCHED;
            } else {
            PG8_LDB(B0, 0, 0); PG8_SCHED; PG8_LDA(At, 0, 0); PG8_STAGE(PG8_SA(1, 1), a1 + hstep, voffA);
            PG8_WAIT_L(8); PG8_BAR; PG8_WAIT_L(0); PG8_MMA(0, 0, At, B0); PG8_BAR; PG8_SCHED;
            PG8_LDB(B1, 0, 1); PG8_STAGE(PG8_SB(0, 0), b2, voffB);
            PG8_BAR; PG8_WAIT_L(0); PG8_MMA(0, 1, At, B1); PG8_BAR;
            PG8_LDA(At, 0, 1); PG8_STAGE(PG8_SA(0, 0), a2, voffA);
            PG8_BAR; PG8_WAIT_L(0); PG8_MMA(1, 0, At, B0); PG8_BAR; PG8_SCHED;
            PG8_STAGE(PG8_SB(0, 1), b2 + hstep, voffB);
            PG8_WAIT_V(6); PG8_BAR; PG8_MMA(1, 1, At, B1); PG8_BAR;
            PG8_LDB(B0, 1, 0); PG8_SCHED; PG8_LDA(At, 1, 0); PG8_STAGE(PG8_SA(0, 1), a2 + hstep, voffA);
            PG8_WAIT_L(8); PG8_BAR; PG8_WAIT_L(0); PG8_MMA(0, 0, At, B0); PG8_BAR; PG8_SCHED;
            PG8_LDB(B1, 1, 1); PG8_STAGE(PG8_SB(1, 0), b3, voffB);
            PG8_BAR; PG8_WAIT_L(0); PG8_MMA(0, 1, At, B1); PG8_BAR;
            PG8_LDA(At, 1, 1); PG8_STAGE(PG8_SA(1, 0), a3, voffA);
            PG8_BAR; PG8_WAIT_L(0); PG8_MMA(1, 0, At, B0); PG8_BAR; PG8_SCHED;
            PG8_STAGE(PG8_SB(1, 1), b3 + hstep, voffB);
            PG8_WAIT_V(6); PG8_BAR; PG8_MMA(1, 1, At, B1); PG8_BAR;
            }
        }
        if constexpr (ALIGN_EPI) { if (wr == 0) PG8_BAR; }
        if constexpr (!Epi::AFTER_DRAIN) { E(acc, cur, wr, wc, fr, fq); S.done(cur); }
        if (!has_next) break;
#pragma unroll
        for (int a = 0; a < 2; ++a)
#pragma unroll
            for (int b = 0; b < 2; ++b)
#pragma unroll
                for (int m = 0; m < 4; ++m)
#pragma unroll
                    for (int n = 0; n < 2; ++n) acc[a][b][m][n] = (f32x4){0.f, 0.f, 0.f, 0.f};
        if constexpr (Epi::HAS_INIT) E.init(acc, nxt, wr, wc, fr, fq);
        cur = nxt; cA = nA; cB = nB; ++ui;
        if constexpr (ALIGN_EPI) { if (wr == 1) PG8_BAR; }
    }
    PG8_WAIT_V(0);
    if constexpr (!ALIGN_EPI) { if (wr == 0) PG8_BAR; }
    PG8_BAR;
    static_assert(!Epi::AFTER_DRAIN, "no after-drain epilogues in this kernel");
#undef PG8_SA
#undef PG8_SB
#undef PG8_STAGE
#undef PG8_LDA
#undef PG8_LDB
#undef PG8_MMA
#undef PG8_WAIT_V
#undef PG8_WAIT_L
#undef PG8_BAR
#undef PG8_SCHED
}
}

namespace dattn {
using bf16x8 = __attribute__((ext_vector_type(8))) short;
using s16x4 = __attribute__((ext_vector_type(4))) short;
using f32x16 = __attribute__((ext_vector_type(16))) float;
using f32x4 = __attribute__((ext_vector_type(4))) float;
using u32x4 = __attribute__((ext_vector_type(4))) unsigned;
constexpr int NW = 8, QBLK = 32, KVBLK = 64, QB = 256;
constexpr int SHM_V = 16384, SHM_K = 8192;
constexpr int NSLOT = 3;
constexpr int L_V = 0, L_K = NSLOT * SHM_V, L_WS = L_K + NSLOT * SHM_K, L_TAB = L_WS + NW * 256, L_O0 = L_TAB + 2 * 2048, L_MISC = L_O0 + NW * 8192, L_END = L_MISC + 1024;
constexpr int TAB_OFF = 304;
constexpr float THR = 8.f;
#define SBAR() __builtin_amdgcn_sched_barrier(0)
__device__ __forceinline__ int v_rd_base(int lane) { return ((lane & 3) << 3) | (((lane >> 2) & 3) << 6) | (((lane >> 4) & 1) << 5) | (((lane >> 5) & 1) << 8); }
constexpr int v_rd_off(int d0, int ks, int half) { return d0 * 512 + ks * 4096 + half * 2048; }
__device__ __forceinline__ int crow(int r, int hi) { return (r & 3) + 8 * (r >> 2) + 4 * hi; }
__device__ __forceinline__ unsigned cvtpk(float lo, float hi) { return pg8::cvt_pk_bf16(lo, hi); }

__device__ __forceinline__ void startSM(f32x16& p0, f32x16& p1, bool near, const char* tabp, float shift) {
    if (near) {
#pragma unroll
        for (int r = 0; r < 16; ++r) { const int c = (r & 3) + 8 * (r >> 2);
            p0[r] += *(const float*)(tabp + 4 * (59 - c)); p1[r] += *(const float*)(tabp + 4 * (59 - c - 32)); }
    }
#if 1
    else if (__builtin_expect(shift != 0.f, 0)) {
#pragma unroll
        for (int r = 0; r < 16; ++r) { p0[r] -= shift; p1[r] -= shift; }
    }
#endif
#pragma unroll
    for (int r = 0; r < 16; ++r) p0[r] = __builtin_amdgcn_exp2f(p0[r]);
}
template <bool EXP1>
__device__ __forceinline__ void finishSM(f32x16& p0, f32x16& p1, float& l_reg, bf16x8& pa0, bf16x8& pa1, bf16x8& pa2, bf16x8& pa3) {
    if constexpr (EXP1) {
#pragma unroll
        for (int r = 0; r < 16; ++r) p1[r] = __builtin_amdgcn_exp2f(p1[r]); }
    float ps = 0;
#pragma unroll
    for (int r = 0; r < 16; ++r) ps += p0[r];
#pragma unroll
    for (int r = 0; r < 16; ++r) ps += p1[r];
    l_reg += ps;
#define PK4(P, B_, OUT) do { unsigned a0 = cvtpk(P[B_+0], P[B_+1]), a1 = cvtpk(P[B_+2], P[B_+3]);                          \
        unsigned b0 = cvtpk(P[B_+4], P[B_+5]), b1 = cvtpk(P[B_+6], P[B_+7]);                                             \
        auto r0 = __builtin_amdgcn_permlane32_swap(a0, b0, false, false); auto r1 = __builtin_amdgcn_permlane32_swap(a1, b1, false, false); \
        u32x4 w = {r0[0], r1[0], r0[1], r1[1]}; OUT = *reinterpret_cast<bf16x8*>(&w); } while (0)
    PK4(p0, 0, pa0); PK4(p0, 8, pa1); PK4(p1, 0, pa2); PK4(p1, 8, pa3);
#undef PK4
}
__device__ __forceinline__ void qkt(int kslot, f32x16& p0, f32x16& p1, const char* K_lds, int r32, int hi, const bf16x8* qr) {
    p0 = f32x16{}; p1 = f32x16{};
    const int sw = (r32 >> 1) & 7;
#pragma unroll
    for (int d0 = 0; d0 < 4; ++d0) { const char* a = K_lds + kslot + r32 * 128 + (((2 * d0 + hi) ^ sw) << 4);
        bf16x8 b0 = *reinterpret_cast<const bf16x8*>(a);
        bf16x8 b1 = *reinterpret_cast<const bf16x8*>(a + 32 * 128);
        p0 = __builtin_amdgcn_mfma_f32_32x32x16_bf16(b0, qr[d0], p0, 0, 0, 0);
        p1 = __builtin_amdgcn_mfma_f32_32x32x16_bf16(b1, qr[d0], p1, 0, 0, 0); }
}
__device__ __forceinline__ void pv_tile(f32x16* o, int vb0  , bf16x8 pa0, bf16x8 pa1, bf16x8 pa2, bf16x8 pa3) {
#define TRRD(dst, off) asm volatile("ds_read_b64_tr_b16 %0, %1 offset:%2" : "=&v"(dst) : "v"(vb0), "i"(off) : "memory")
#define PV_D0(d0) do { s16x4 l0, l1, l2, l3, h0, h1, h2, h3; constexpr int b_ = v_rd_off(d0, 0, 0);     \
        TRRD(l0, b_); TRRD(h0, b_ + 2048); TRRD(l1, b_ + 4096); TRRD(h1, b_ + 6144); TRRD(l2, b_ + 8192); TRRD(h2, b_ + 10240); TRRD(l3, b_ + 12288); TRRD(h3, b_ + 14336); \
        asm volatile("s_waitcnt lgkmcnt(0)" ::: "memory"); SBAR();                                                                                    \
        o[d0] = __builtin_amdgcn_mfma_f32_32x32x16_bf16(pa0, (bf16x8){l0[0], l0[1], l0[2], l0[3], h0[0], h0[1], h0[2], h0[3]}, o[d0], 0, 0, 0);   \
        o[d0] = __builtin_amdgcn_mfma_f32_32x32x16_bf16(pa1, (bf16x8){l1[0], l1[1], l1[2], l1[3], h1[0], h1[1], h1[2], h1[3]}, o[d0], 0, 0, 0);   \
        o[d0] = __builtin_amdgcn_mfma_f32_32x32x16_bf16(pa2, (bf16x8){l2[0], l2[1], l2[2], l2[3], h2[0], h2[1], h2[2], h2[3]}, o[d0], 0, 0, 0);   \
        o[d0] = __builtin_amdgcn_mfma_f32_32x32x16_bf16(pa3, (bf16x8){l3[0], l3[1], l3[2], l3[3], h3[0], h3[1], h3[2], h3[3]}, o[d0], 0, 0, 0); } while (0)
    PV_D0(0); PV_D0(1); PV_D0(2); PV_D0(3);
#undef PV_D0
#undef TRRD
}

typedef __attribute__((address_space(3))) const char* lds_cptr;
typedef short v4i16_t __attribute__((ext_vector_type(4)));
__device__ __forceinline__ s16x4 vtr(lds_cptr p) { return __builtin_bit_cast(s16x4, __builtin_amdgcn_ds_read_tr16_b64_v4i16((__attribute__((address_space(3))) v4i16_t*)p)); }
template <int VAR>
__device__ __forceinline__ void step(f32x16& x0, f32x16& x1, f32x16& y0, f32x16& y1, float& l_reg, f32x16* o, const bf16x8* qr,
                                     const char* Kc  , int sw, int hi, lds_cptr vb  ,
                                     bool near, const char* tabp, float shift) {
    bf16x8 ka[4], kb[4], pa0, pa1, pa2, pa3;
    s16x4 lo[4], hv[4];
    unsigned a0, a1, b0, b1;
#define KRD(d0) do { if constexpr (VAR & 4) break; const char* a_ = Kc + (((2 * (d0) + hi) ^ sw) << 4); ka[d0] = *reinterpret_cast<const bf16x8*>(a_); kb[d0] = *reinterpret_cast<const bf16x8*>(a_ + 32 * 128); } while (0)
#define VRD(i) do { if constexpr (VAR & 2) break; lo[(i) & 3] = vtr(vb + v_rd_off((i) >> 2, (i) & 3, 0)); hv[(i) & 3] = vtr(vb + v_rd_off((i) >> 2, (i) & 3, 1)); } while (0)
#define VFR(i) (bf16x8){lo[(i) & 3][0], lo[(i) & 3][1], lo[(i) & 3][2], lo[(i) & 3][3], hv[(i) & 3][0], hv[(i) & 3][1], hv[(i) & 3][2], hv[(i) & 3][3]}
#define SUM4(Y, b) do { if constexpr (!(VAR & 8)) { ps += (Y[b] + Y[(b) + 1]) + (Y[(b) + 2] + Y[(b) + 3]); asm volatile("" : "+v"(ps)); } } while (0)
#define PKA(Y, b) do { if constexpr (!(VAR & 8)) { a0 = cvtpk(Y[b], Y[(b) + 1]); a1 = cvtpk(Y[(b) + 2], Y[(b) + 3]); } } while (0)
#define PKB(Y, b, OUT) do { if constexpr (VAR & 8) { OUT = ka[0]; asm volatile("" : "+v"(OUT)); } else { b0 = cvtpk(Y[b], Y[(b) + 1]); b1 = cvtpk(Y[(b) + 2], Y[(b) + 3]); auto r0_ = __builtin_amdgcn_permlane32_swap(a0, b0, false, false); auto r1_ = __builtin_amdgcn_permlane32_swap(a1, b1, false, false); \
                            u32x4 w_ = {r0_[0], r1_[0], r0_[1], r1_[1]}; OUT = *reinterpret_cast<bf16x8*>(&w_); asm volatile("" : "+v"(OUT)); } } while (0)
#define QKM(X, KF, QF, C) do { if constexpr (VAR & 4) { X = C; asm volatile("" : "+v"(X)); } else X = __builtin_amdgcn_mfma_f32_32x32x16_bf16(KF, QF, C, 0, 0, 0); } while (0)
    float ps = 0.f;
    if constexpr (VAR & 4) { ka[0] = qr[0]; ka[1] = qr[1]; ka[2] = qr[2]; ka[3] = qr[3]; kb[0] = qr[0]; kb[1] = qr[1]; kb[2] = qr[2]; kb[3] = qr[3]; }
    KRD(0); KRD(1); SBAR();
    { const f32x16 z = f32x16{};
      QKM(x0, ka[0], qr[0], z);  SUM4(y0, 0); PKA(y0, 0);       SBAR();
      QKM(x1, kb[0], qr[0], z);  SUM4(y0, 4); PKB(y0, 4, pa0);  KRD(2); SBAR(); }
    QKM(x0, ka[1], qr[1], x0); SUM4(y0, 8); PKA(y0, 8);       SBAR();
    QKM(x1, kb[1], qr[1], x1); SUM4(y0, 12); PKB(y0, 12, pa1); KRD(3); SBAR();
    QKM(x0, ka[2], qr[2], x0); SUM4(y1, 0); PKA(y1, 0);       SBAR();
    QKM(x1, kb[2], qr[2], x1); SUM4(y1, 4); PKB(y1, 4, pa2);  SBAR();
    QKM(x0, ka[3], qr[3], x0); SUM4(y1, 8); PKA(y1, 8);       SBAR();
    QKM(x1, kb[3], qr[3], x1); SUM4(y1, 12); PKB(y1, 12, pa3); VRD(0); VRD(1); SBAR();
    VRD(2); VRD(3); SBAR();
    if (near) {
        asm volatile("s_nop 15\n\ts_nop 7" : "+v"(x0), "+v"(x1));
#pragma unroll
        for (int r = 0; r < 16; ++r) { const int c = (r & 3) + 8 * (r >> 2);
            const float t0 = *(const float*)(tabp + 4 * (59 - c)), t1 = *(const float*)(tabp + 4 * (59 - c - 32));
            asm volatile("v_add_f32 %0, %0, %1" : "+v"(x0[r]) : "v"(t0)); asm volatile("v_add_f32 %0, %0, %1" : "+v"(x1[r]) : "v"(t1)); }
    } else if (__builtin_expect(shift != 0.f, 0)) {
        asm volatile("s_nop 15\n\ts_nop 7" : "+v"(x0), "+v"(x1));
#pragma unroll
        for (int r = 0; r < 16; ++r) { asm volatile("v_sub_f32 %0, %0, %1" : "+v"(x0[r]) : "v"(shift)); asm volatile("v_sub_f32 %0, %0, %1" : "+v"(x1[r]) : "v"(shift)); }
    }
    SBAR();
#define GAPB(i, PA) do { if constexpr (!(VAR & 2)) o[(i) >> 2] = __builtin_amdgcn_mfma_f32_32x32x16_bf16(PA, VFR(i), o[(i) >> 2], 0, 0, 0); else asm volatile("" :: "v"(PA)); \
                         if constexpr (!(VAR & 1)) { x0[i] = __builtin_amdgcn_exp2f(x0[i]); x1[i] = __builtin_amdgcn_exp2f(x1[i]); } asm volatile("" : "+v"(x0), "+v"(x1)); \
                         if ((i) + 4 < 16) VRD((i) + 4); SBAR(); } while (0)
    GAPB(0, pa0); GAPB(1, pa1); GAPB(2, pa2); GAPB(3, pa3); GAPB(4, pa0); GAPB(5, pa1); GAPB(6, pa2); GAPB(7, pa3);
    GAPB(8, pa0); GAPB(9, pa1); GAPB(10, pa2); GAPB(11, pa3); GAPB(12, pa0); GAPB(13, pa1); GAPB(14, pa2); GAPB(15, pa3);
    l_reg += ps;
#undef QKM
#undef KRD
#undef VRD
#undef VFR
#undef SUM4
#undef PKA
#undef PKB
#undef GAPB
}

struct BlockRef { const bf16_t* Q; const bf16_t* K; const bf16_t* V; int P0; int c; int m0; int h; };
struct Seam { bf16x8 qr[4];
#ifdef PROBE_WAITCYC
    unsigned long long wcyc;
#endif
};
struct Outs { const bf16_t* SG; bf16_t* BR; const float* subg; float lam; };
#define LASP __attribute__((address_space(3)))
#define WAIT_BAR() asm volatile("s_waitcnt vmcnt(0) lgkmcnt(0)\n\ts_barrier" ::: "memory")
#define VMW_N(n) asm volatile("s_waitcnt vmcnt(" #n ")" ::: "memory")
#define WAIT_BAR_N(n) asm volatile("s_waitcnt vmcnt(" #n ") lgkmcnt(0)\n\ts_barrier" ::: "memory")
__device__ __forceinline__ void glds16(const void* gsrc, unsigned lds_dst) { unsigned keep;
    asm volatile("s_mov_b32 %0, m0\n\ts_mov_b32 m0, %2\n\ts_nop 0\n\tglobal_load_lds_dwordx4 %1, off\n\ts_mov_b32 m0, %0" : "=&s"(keep) : "v"(gsrc), "s"(lds_dst) : "memory"); }
#define DMA_K(Kp, j, slot) glds16((const char*)((Kp) + (size_t)(j) * 4096) + tid * 16, (unsigned)__builtin_amdgcn_readfirstlane(lds0 + L_K + (slot) * SHM_K + wid * 1024))
#define DMA_V(Vp, j, slot) do { glds16((const char*)((Vp) + (size_t)(j) * 8192) + tid * 16, (unsigned)__builtin_amdgcn_readfirstlane(lds0 + L_V + (slot) * SHM_V + wid * 1024)); \
                                glds16((const char*)((Vp) + (size_t)(j) * 8192 + 4096) + tid * 16, (unsigned)__builtin_amdgcn_readfirstlane(lds0 + L_V + (slot) * SHM_V + 8192 + wid * 1024)); } while (0)
__device__ __forceinline__ void dattn_issue(const BlockRef& b, char* lds, Seam& S) {
    int tid = threadIdx.x; asm volatile("" : "+v"(tid));
    const int wid = __builtin_amdgcn_readfirstlane(tid >> 6), lane = tid & 63, r32 = lane & 31, hi = lane >> 5;
    const unsigned lds0 = (unsigned)(uintptr_t)lds;
    DMA_K(b.K, 0, 0); DMA_V(b.V, 0, 0); DMA_K(b.K, 1, 1); DMA_V(b.V, 1, 1); DMA_K(b.K, 2, 2);
    int qoff = (wid * QBLK + r32) * AW + hi * 8; asm volatile("" : "+v"(qoff));
#pragma unroll
    for (int d0 = 0; d0 < 4; ++d0) S.qr[d0] = __builtin_nontemporal_load((const bf16x8*)(b.Q + qoff + d0 * 16));
}

#ifdef PROBE_WAITCYC
#define WC0() const unsigned long long wc0_ = __builtin_amdgcn_s_memtime()
#define WC1() S.wcyc += __builtin_amdgcn_s_memtime() - wc0_
#else
#define WC0() do { } while (0)
#define WC1() do { } while (0)
#endif
template <int VAR>
__device__ __forceinline__ void dattn_block(const BlockRef& cur, const BlockRef& nxt, bool has_next, char* lds, Seam& S, const Outs& OU) {
    const int tid = threadIdx.x, wid = __builtin_amdgcn_readfirstlane(tid >> 6), lane = tid & 63, r32 = lane & 31, hi = lane >> 5;
    const int NT = (cur.P0 + QB - 1) / KVBLK + 1;
    const int qlo = cur.P0 + wid * QBLK, qm = qlo + r32 - 4 * hi;
    const unsigned lds0 = (unsigned)(uintptr_t)lds;
    char* V_lds = lds + L_V; char* K_lds = lds + L_K;
    const char* tab = lds + L_TAB + cur.c * 2048;
    const float shift = *(const float*)(lds + L_MISC);
    float l_reg = 0; f32x16 o[4] = {};
    const lds_cptr vb3 = (lds_cptr)V_lds + v_rd_base(lane);
    const int sw = (r32 >> 1) & 7; const char* Kl = K_lds + r32 * 128;
    const bf16_t* Kh = cur.K; const bf16_t* Vh = cur.V;
#define KBASE(t) ((t) * KVBLK)
#define NEAR(t) (KBASE(t) > qlo - 176)
#define TABP(t) (tab + 4 * (qm - KBASE(t) + TAB_OFF - 59))
    f32x16 pA0, pA1, pB0, pB1; bf16x8 pa0, pa1, pa2, pa3;
    int s_prev = 0, s_cur = 0, s_next = 1;
#define ROT() do { s_prev = s_cur; s_cur = s_next; s_next = (s_next == NSLOT - 1) ? 0 : s_next + 1; } while (0)
    WAIT_BAR();
    SBAR(); qkt(0, pA0, pA1, K_lds, r32, hi, S.qr);
    startSM(pA0, pA1, NEAR(0), TABP(0), shift);
#pragma unroll
    for (int r = 0; r < 16; ++r) pA1[r] = __builtin_amdgcn_exp2f(pA1[r]);
    WAIT_BAR();
    ROT();
#define STEP(PX0, PX1, PY0, PY1, t) do {                                                                                      \
        if ((t) + 2 < NT) DMA_K(Kh, (t) + 2, s_prev);                                                                         \
        if ((t) + 1 < NT) DMA_V(Vh, (t) + 1, s_next);                                                                         \
        SBAR();                                                                                                               \
        step<VAR>(PX0, PX1, PY0, PY1, l_reg, o, S.qr, Kl + s_cur * SHM_K, sw, hi, vb3 + s_prev * SHM_V, NEAR(t), TABP(t), shift);         \
          \
        WC0(); if ((t) + 2 < NT) { VMW_N(3); } else if ((t) + 1 < NT) { VMW_N(2); } else { VMW_N(0); } WC1();     \
        asm volatile("s_waitcnt lgkmcnt(0)\n\ts_barrier" ::: "memory"); ROT(); } while (0)
    int t = 1;
    for (; t + 1 < NT; t += 2) { STEP(pB0, pB1, pA0, pA1, t); STEP(pA0, pA1, pB0, pB1, t + 1); }
    if (t < NT) {
        STEP(pB0, pB1, pA0, pA1, t);
        pA0 = pB0; pA1 = pB1;
    }
    int tid_t = threadIdx.x; asm volatile("" : "+v"(tid_t));
    const int lane_t = tid_t & 63, r32_t = lane_t & 31, hi_t = lane_t >> 5;
    const int vb0_t = (int)(uintptr_t)V_lds + v_rd_base(lane_t) + s_prev * SHM_V;
    finishSM<false>(pA0, pA1, l_reg, pa0, pa1, pa2, pa3); SBAR();
    pv_tile(o, vb0_t, pa0, pa1, pa2, pa3);
    WAIT_BAR();
    if (has_next) dattn_issue(nxt, lds, S);
    { auto rr = __builtin_amdgcn_permlane32_swap(__float_as_uint(l_reg), __float_as_uint(l_reg), false, false); l_reg = __uint_as_float(rr[0]) + __uint_as_float(rr[1]); }
    float* li_l = (float*)(lds + L_WS) + wid * 64;
    if (hi_t == 0) li_l[r32_t] = l_reg; asm volatile("s_waitcnt lgkmcnt(0)" ::: "memory");
    float rli[16];
#pragma unroll
    for (int r = 0; r < 16; ++r) rli[r] = __builtin_amdgcn_rcpf(li_l[crow(r, hi_t)]);
    unsigned* o0w = (unsigned*)(lds + L_O0 + wid * 8192);
    if (cur.c == 0) {
#pragma unroll
        for (int d0 = 0; d0 < 4; ++d0)
#pragma unroll
            for (int r = 0; r < 16; r += 2) o0w[(d0 * 8 + (r >> 1)) * 64 + lane_t] = cvtpk(o[d0][r] * rli[r], o[d0][r + 1] * rli[r + 1]);
    } else {
        const float lam = OU.lam;
        const int ch = lane_t & 15;
        u32x4 gsg[8];
#pragma unroll
        for (int i = 0; i < 8; ++i) gsg[i] = __builtin_nontemporal_load((const u32x4*)(OU.SG + ((size_t)cur.m0 + wid * QBLK + i * 4 + (lane_t >> 4)) * AW + cur.h * 128 + ch * 8));
        const f32x4 sg0 = *(const f32x4*)(OU.subg + ch * 8), sg1 = *(const f32x4*)(OU.subg + ch * 8 + 4);
        unsigned short* stg = (unsigned short*)o0w;
#pragma unroll
        for (int d0 = 0; d0 < 4; ++d0)
#pragma unroll
            for (int r = 0; r < 16; r += 2) { const unsigned w = o0w[(d0 * 8 + (r >> 1)) * 64 + lane_t];
                o[d0][r] = __builtin_bit_cast(float, w << 16) - lam * (o[d0][r] * rli[r]);
                o[d0][r + 1] = __builtin_bit_cast(float, w & 0xffff0000u) - lam * (o[d0][r + 1] * rli[r + 1]); }
        asm volatile("s_waitcnt lgkmcnt(0)" ::: "memory");
#pragma unroll
        for (int r = 0; r < 16; ++r) { const int orow = crow(r, hi_t);
#pragma unroll
            for (int d0 = 0; d0 < 4; ++d0) stg[orow * 128 + d0 * 32 + r32_t] = (unsigned short)(cvtpk(o[d0][r], 0.f) & 0xffffu); }
        asm volatile("s_waitcnt lgkmcnt(0)" ::: "memory");
        constexpr float SC = 1.f - LAM_INIT;
#pragma unroll
        for (int i = 0; i < 8; ++i) { const int row = i * 4 + (lane_t >> 4);
            const u32x4 v = *(const u32x4*)(stg + row * 128 + ch * 8);
            float x0 = __builtin_bit_cast(float, v.x << 16), x1 = __builtin_bit_cast(float, v.x & 0xffff0000u), x2 = __builtin_bit_cast(float, v.y << 16), x3 = __builtin_bit_cast(float, v.y & 0xffff0000u);
            float x4 = __builtin_bit_cast(float, v.z << 16), x5 = __builtin_bit_cast(float, v.z & 0xffff0000u), x6 = __builtin_bit_cast(float, v.w << 16), x7 = __builtin_bit_cast(float, v.w & 0xffff0000u);
            float s = ((x0 * x0 + x1 * x1) + (x2 * x2 + x3 * x3)) + ((x4 * x4 + x5 * x5) + (x6 * x6 + x7 * x7));
            s += __shfl_xor(s, 1); s += __shfl_xor(s, 2); s += __shfl_xor(s, 4); s += __shfl_xor(s, 8);
            const float rn = rsqrtf(s * (1.f / 128.f) + EPS) * SC;
            const u32x4 g = gsg[i];
            u32x4 w;
            w.x = cvtpk(x0 * rn * __builtin_bit_cast(float, g.x << 16) * sg0[0], x1 * rn * __builtin_bit_cast(float, g.x & 0xffff0000u) * sg0[1]);
            w.y = cvtpk(x2 * rn * __builtin_bit_cast(float, g.y << 16) * sg0[2], x3 * rn * __builtin_bit_cast(float, g.y & 0xffff0000u) * sg0[3]);
            w.z = cvtpk(x4 * rn * __builtin_bit_cast(float, g.z << 16) * sg1[0], x5 * rn * __builtin_bit_cast(float, g.z & 0xffff0000u) * sg1[1]);
            w.w = cvtpk(x6 * rn * __builtin_bit_cast(float, g.w << 16) * sg1[2], x7 * rn * __builtin_bit_cast(float, g.w & 0xffff0000u) * sg1[3]);
            *(u32x4*)(OU.BR + ((size_t)cur.m0 + wid * QBLK + row) * 1024 + cur.h * 128 + ch * 8) = w; }
    }
    asm volatile("s_waitcnt lgkmcnt(0)" ::: "memory");
#undef KBASE
#undef NEAR
#undef TABP
#undef ROT
#undef STEP
}
#undef DMA_K
#undef DMA_V
#undef WAIT_BAR
#undef WAIT_BAR_N
#undef VMW_N
#undef LASP
#undef SBAR
}

constexpr int NWAVES = 8;
constexpr int RING_OFF = 0, RING_BYTES = 131072;
constexpr int LDS_BYTES = 163840;
constexpr int LDSCTL_OFF = LDS_BYTES - 1024, MISC_OFF = LDSCTL_OFF + 320;
static_assert(dattn::L_END <= LDSCTL_OFF && RING_BYTES <= LDSCTL_OFF, "LDS map");
constexpr int CW_ROWQ = 64;
constexpr int CW_BAR = 4096;
constexpr size_t CTL_ZERO_BYTES = 128 * 1024;

struct Frame {
    LAS unsigned char* lds;
    volatile LAS unsigned* MISC;
    int tid, lane, wave, vcu, G;
};

__device__ __forceinline__ int nat_col(int p) {
    const int pn = p >> 8, t = p & 255;
    if (pn < 4) { const int bj = t >> 7, wc = (t >> 5) & 3, r = t & 31; return pn * 256 + 64 * wc + 32 * bj + r; }
    if (pn >= 8 && pn < 16) { const int bj = t >> 7, wc = (t >> 5) & 3, fq = (t >> 3) & 3, n = (t >> 2) & 1, i = t & 3;
        const int qty = bj == 0 ? (n == 0 ? 1 : 2) : (n == 0 ? 0 : 3);
        return 2048 + 512 * qty + 64 * (pn - 8) + 16 * wc + 4 * fq + i; }
    if (pn >= 16) { const int bj = t >> 7; return 4096 + 1024 * bj + 128 * (pn - 16) + (t & 127); }
    return p;
}
template <bool PERMUTE, bool SCALE>
__device__ __forceinline__ void p0_transpose_wg(Frame& F, const float* W, int K, int N, bf16* WT, const float* g, int item) {
    LAS float* T = (LAS float*)(F.lds + RING_OFF);
    const int nblk = N / 256, kb = item / nblk, nb = item % nblk, k0 = 64 * kb, n0 = 256 * nb;
    const int ncol = PERMUTE ? nat_col(n0 + 4 * F.lane) : n0 + 4 * F.lane;
    f32x4 v[8];
#pragma unroll
    for (int i = 0; i < 8; ++i) v[i] = __builtin_nontemporal_load((const GAS f32x4*)(W + (size_t)(k0 + 8 * F.wave + i) * N + ncol));
#pragma unroll
    for (int i = 0; i < 8; ++i) { const int kk = 8 * F.wave + i; f32x4 x = v[i]; if (SCALE) x = x * g[k0 + kk];
        T[kk * 257 + 4 * F.lane + 0] = x.x; T[kk * 257 + 4 * F.lane + 1] = x.y; T[kk * 257 + 4 * F.lane + 2] = x.z; T[kk * 257 + 4 * F.lane + 3] = x.w; }
    __syncthreads();
    const int c = F.lane & 7;
#pragma unroll
    for (int j = 0; j < 4; ++j) { const int n = 32 * F.wave + 8 * j + (F.lane >> 3); const LAS float* s = T + (8 * c) * 257 + n;
        v4u o; o.x = pk2(s[0 * 257], s[1 * 257]); o.y = pk2(s[2 * 257], s[3 * 257]); o.z = pk2(s[4 * 257], s[5 * 257]); o.w = pk2(s[6 * 257], s[7 * 257]);
        *(GAS v4u*)(WT + (size_t)(n0 + n) * K + k0 + 8 * c) = o; }
    __syncthreads();
}
__device__ __forceinline__ void rms_rows4_to_bf16(int lane, const float* x0, bf16* o0, size_t stride) {
    f32x4 v[4][4];
#pragma unroll
    for (int r = 0; r < 4; ++r) { const GAS f32x4* xr = (const GAS f32x4*)(x0 + r * stride) + lane;
#pragma unroll
        for (int j = 0; j < 4; ++j) v[r][j] = __builtin_nontemporal_load(&xr[64 * j]); }
#pragma unroll
    for (int r = 0; r < 4; ++r) { float s = 0.f;
#pragma unroll
        for (int j = 0; j < 4; ++j) s += (v[r][j].x * v[r][j].x + v[r][j].y * v[r][j].y) + (v[r][j].z * v[r][j].z + v[r][j].w * v[r][j].w);
        const float rs = rsqrtf(wave_sum(s) * (1.f / DM) + EPS);
        GAS unsigned long long* o8 = (GAS unsigned long long*)(o0 + r * stride) + lane;
#pragma unroll
        for (int j = 0; j < 4; ++j) o8[64 * j] = (unsigned long long)pk2(v[r][j].x * rs, v[r][j].y * rs) | ((unsigned long long)pk2(v[r][j].z * rs, v[r][j].w * rs) << 32); }
}

template <int NBLK>
__device__ __forceinline__ void p0_meta_task(Frame& F, const Ptrs& P, int task) {
    LAS float* xn = (LAS float*)(F.lds + RING_OFF);
    LAS float* part = (LAS float*)(F.lds + RING_OFF + 65536);
    for (int r = F.wave * 2; r < F.wave * 2 + 2; ++r) {
        float v[16]; float s = 0.f;
#pragma unroll
        for (int j = 0; j < 16; ++j) { v[j] = P.meta[(size_t)r * DM + j * 64 + F.lane]; s += v[j] * v[j]; }
        const float rs = rsqrtf(wave_sum(s) * (1.f / DM) + EPS);
#pragma unroll
        for (int j = 0; j < 16; ++j) xn[r * DM + j * 64 + F.lane] = v[j] * rs * P.norm_g[j * 64 + F.lane];
    }
    __syncthreads();
    const int type = task >> 3, g = task & 7;
    const int c0 = type == 0 ? 512 + 64 * g : type == 1 ? 1024 + 64 * g : 2048 + 512 + 64 * g;
    const int c1 = 2048 + 1024 + 64 * g;
    f32x4 acc[8];
#pragma unroll
    for (int i = 0; i < 8; ++i) acc[i] = (f32x4){0.f, 0.f, 0.f, 0.f};
    const int fr = F.lane & 15, fk = F.lane >> 4;
    for (int kc = 0; kc < 4; ++kc) {
        float bv[8][NBLK];
#pragma unroll
        for (int s = 0; s < 8; ++s) { const int k = F.wave * 128 + (kc * 8 + s) * 4 + fk;
#pragma unroll
            for (int blk = 0; blk < NBLK; ++blk) bv[s][blk] = P.w_in[(size_t)k * INC + (blk < 4 ? c0 + 16 * blk : c1 + 16 * (blk - 4)) + fr]; }
        asm volatile("" ::: "memory");
#pragma unroll
        for (int s = 0; s < 8; ++s) { const float a = xn[fr * DM + F.wave * 128 + (kc * 8 + s) * 4 + fk];
#pragma unroll
            for (int blk = 0; blk < NBLK; ++blk) acc[blk] = __builtin_amdgcn_mfma_f32_16x16x4f32(a, bv[s][blk], acc[blk], 0, 0, 0); }
    }
#pragma unroll
    for (int blk = 0; blk < 8; ++blk)
#pragma unroll
        for (int reg = 0; reg < 4; ++reg) part[(F.wave * 16 + 4 * fk + reg) * 128 + 16 * blk + fr] = acc[blk][reg];
    __syncthreads();
    bf16* KI = (bf16*)(P.ws + WS_K); bf16* VI = (bf16*)(P.ws + WS_V); bf16* U = (bf16*)(P.ws + WS_U);
    for (int r = F.wave * 2; r < F.wave * 2 + 2; ++r) {
        float v0 = 0.f, v1 = 0.f;
#pragma unroll
        for (int w = 0; w < 8; ++w) { v0 += part[(w * 16 + r) * 128 + F.lane]; v1 += part[(w * 16 + r) * 128 + 64 + F.lane]; }
        if (type == 0) {
            const float ss = wave_sum(v0 * v0);
            const unsigned short o = (unsigned short)f2bf(v0 * rsqrtf(ss * (1.f / 64.f) + EPS) * P.k_norm_g[F.lane]);
            for (int b = 0; b < BATCH; ++b) KI[kimg_off(b, g >> 1, g & 1, r, F.lane)] = o;
        } else if (type == 1) {
            const unsigned short o = (unsigned short)f2bf(v0);
            for (int b = 0; b < BATCH; ++b) VI[vimg_off(b, g >> 1, r, (g & 1) * 64 + F.lane)] = o;
        } else {
            const unsigned short o = (unsigned short)f2bf(v0 * v1);
            for (int b = 0; b < BATCH; ++b) U[((size_t)b * LTOK + r) * CW + 64 * g + F.lane] = o;
        }
    }
    __syncthreads();
}

#ifdef PROBE_AMP
#define STAMP(k) do { if (blockIdx.x == 0 && F.tid == 0) { const unsigned long long t_ = rt(); F.MISC[16 + 2 * (k)] = (unsigned)t_; F.MISC[17 + 2 * (k)] = (unsigned)(t_ >> 32); } } while (0)
#else
#define STAMP(k) do { } while (0)
#endif
__device__ __forceinline__ void p0_prologue(Frame& F, const Ptrs& P) {
    if (F.vcu < 16) p0_meta_task<4>(F, P, F.vcu); else if (F.vcu < 24) p0_meta_task<8>(F, P, F.vcu);
    STAMP(6);
    const int gw = F.vcu * NWAVES + F.wave, NGW = F.G * NWAVES;
    bf16* WIN = (bf16*)(P.ws + WS_WIN); bf16* WBR = (bf16*)(P.ws + WS_WBR); bf16* WOUT = (bf16*)(P.ws + WS_WOUT); bf16* XB = (bf16*)(P.ws + WS_XB);
    constexpr int I_IN = (DM / 64) * (INC / 256), I_SQ = (DM / 64) * (DM / 256);
    for (int it = F.vcu; it < I_IN + 2 * I_SQ; it += F.G) {
        int r = it;
        if (r < I_IN) { p0_transpose_wg<true, true>(F, P.w_in, DM, INC, WIN, P.norm_g, r); continue; } r -= I_IN;
        if (r < I_SQ) { p0_transpose_wg<false, false>(F, P.w_branch, DM, DM, WBR, nullptr, r); continue; } r -= I_SQ;
        p0_transpose_wg<false, false>(F, P.w_out, DM, DM, WOUT, nullptr, r);
    }
    STAMP(7);
    for (;;) {
        if (F.tid == 0) F.MISC[12] = __hip_atomic_fetch_add((unsigned*)(P.ws + WS_CTL) + CW_ROWQ, 1u, __ATOMIC_RELAXED, __HIP_MEMORY_SCOPE_AGENT);
        __syncthreads();
        const unsigned c = F.MISC[12];
        __syncthreads();
        if (c >= (unsigned)(MROWS / 32)) break;
        const size_t m0 = (size_t)c * 32 + F.wave * 4;
        rms_rows4_to_bf16(F.lane, P.x + m0 * DM, XB + m0 * DM, (size_t)DM);
    }
    STAMP(8);
    { GAS v4u* KI = (GAS v4u*)(P.ws + WS_K); GAS v4u* VI = (GAS v4u*)(P.ws + WS_V); const v4u z = {0u, 0u, 0u, 0u};
      const int gt = F.vcu * 512 + F.tid, NT_ = F.G * 512;
      for (int i = gt; i < 64 * 512; i += NT_) KI[((size_t)(i >> 9) * NKT + 64) * 512 + (i & 511)] = z;
      for (int i = gt; i < 32 * 1024; i += NT_) VI[((size_t)(i >> 10) * NKT + 64) * 1024 + (i & 1023)] = z; }
}

__device__ __forceinline__ void conv_fixup(Frame& F, const Ptrs& P) {
    const bf16* U = (const bf16*)(P.ws + WS_U); const bf16* GB = (const bf16*)(P.ws + WS_GB); bf16* BR = (bf16*)(P.ws + WS_BR);
    const int gw = F.vcu * NWAVES + F.wave, NGW = F.G * NWAVES, ch0 = F.lane * 8;
    const f32x4 w0a = *(const f32x4*)(P.conv_w + ch0), w0b = *(const f32x4*)(P.conv_w + ch0 + 4);
    const f32x4 w1a = *(const f32x4*)(P.conv_w + CW + ch0), w1b = *(const f32x4*)(P.conv_w + CW + ch0 + 4);
    const f32x4 w2a = *(const f32x4*)(P.conv_w + 2 * CW + ch0), w2b = *(const f32x4*)(P.conv_w + 2 * CW + ch0 + 4);
    for (int it = gw; it < MROWS / 32; it += NGW) {
        const int m = (it >> 1) * 64 + (it & 1), b = m / SEQ, s = m % SEQ; const size_t ur = (size_t)b * LTOK + s + NMETA;
        const v4u um2 = *(const GAS v4u*)(U + (ur - 2) * CW + ch0), um1 = *(const GAS v4u*)(U + (ur - 1) * CW + ch0), u0 = *(const GAS v4u*)(U + ur * CW + ch0), gb = *(const GAS v4u*)(GB + (size_t)m * CW + ch0);
        v4u o;
#define CONV2(W, k0_, wa, wb, wc) { const float ylo = wa[k0_] * bflo_(um2.W) + wb[k0_] * bflo_(um1.W) + wc[k0_] * bflo_(u0.W); \
                                    const float yhi = wa[k0_ + 1] * bfhi_(um2.W) + wb[k0_ + 1] * bfhi_(um1.W) + wc[k0_ + 1] * bfhi_(u0.W); \
                                    o.W = pk2(bflo_(gb.W) * ylo, bfhi_(gb.W) * yhi); }
        CONV2(x, 0, w0a, w1a, w2a) CONV2(y, 2, w0a, w1a, w2a) CONV2(z, 0, w0b, w1b, w2b) CONV2(w, 2, w0b, w1b, w2b)
#undef CONV2
        *(GAS v4u*)(BR + (size_t)m * 1024 + 512 + ch0) = o;
    }
}

__device__ __forceinline__ dattn::BlockRef mk_block(const Ptrs& P, int vcu, int i) {
    const int bh = vcu >> 3, j = vcu & 7, b = bh >> 2, h = bh & 3, qb = (i < 2) ? j : 15 - j, c = i & 1; dattn::BlockRef r;
    r.Q = (const bf16*)(P.ws + WS_Q) + ((size_t)b * SEQ + (size_t)qb * 256) * AW + (h * 2 + c) * 64;
    r.K = (const bf16*)(P.ws + WS_K) + (size_t)((b * NH + h) * 2 + c) * NKT * 4096;
    r.V = (const bf16*)(P.ws + WS_V) + (size_t)(b * NH + h) * NKT * 8192;
    r.P0 = NMETA + qb * 256; r.c = c; r.m0 = b * SEQ + qb * 256; r.h = h; return r;
}

struct Args { Ptrs P; int ph_lo, ph_hi, li, pad; };
__global__ void __launch_bounds__(NWAVES * 64, 2) mega_fwd(Args args) {
    extern __shared__ __attribute__((aligned(16))) unsigned char lds[];
    const Ptrs& P = args.P;
    Frame F;
    F.lds = (LAS unsigned char*)lds;
    F.MISC = (volatile LAS unsigned*)(F.lds + MISC_OFF);
    F.tid = threadIdx.x; F.lane = F.tid & 63; F.wave = __builtin_amdgcn_readfirstlane(F.tid >> 6);
    F.G = gridDim.x; { const int bx = blockIdx.x; F.vcu = (F.G % 8 == 0) ? (bx % 8) * (F.G / 8) + bx / 8 : bx; }
    gu32* ctl = (gu32*)(P.ws + WS_CTL);
    for (int u = F.tid; u < (LDS_BYTES - LDSCTL_OFF) / 4; u += NWAVES * 64) ((LAS unsigned*)(F.lds + LDSCTL_OFF))[u] = 0u;
    __syncthreads();
    XcdBarrier bar = xcd_barrier_post((unsigned*)(ctl + CW_BAR) + args.li * XCD_BAR_WORDS, F.MISC + 8);
    const int lo = args.ph_lo, hi = args.ph_hi;
#ifndef PH_COMPILED
#define PH_COMPILED 0x1F
#endif
#define IN(k) (((PH_COMPILED >> (k)) & 1) && lo <= (k) && (k) < hi)
#define BOTH(k) (IN(k) && IN((k) + 1))
    STAMP(0);
    if (IN(0)) { p0_prologue(F, P); if (BOTH(0)) xcd_barrier(bar); }
    STAMP(1);
    if (IN(1)) {
        pg8::Gemm g{(const bf16*)(P.ws + WS_XB), (const bf16*)(P.ws + WS_WIN), MROWS, INC, DM}; pg8::StaticOrder S; S.init(MROWS, INC, F.G, (int)blockIdx.x);
        pg8::EpiProj E{(bf16*)(P.ws + WS_Q), (bf16*)(P.ws + WS_K), (bf16*)(P.ws + WS_V), (bf16*)(P.ws + WS_SG), (bf16*)(P.ws + WS_U), (bf16*)(P.ws + WS_GB), (bf16*)(P.ws + WS_GATE), (bf16*)(P.ws + WS_GATE + 64 * MiB), (bf16*)(P.ws + WS_BR), P.q_norm_g, P.k_norm_g, P.conv_w};
        pg8::gemm_phase<pg8::EpiProj, pg8::StaticOrder, true, true>(F.lds + RING_OFF, g, S, E);
        if (BOTH(1)) xcd_barrier(bar);
    }
    STAMP(2);
    if (IN(2)) {
        conv_fixup(F, P);
        STAMP(9);
#ifdef PROBE_CLK
        if (blockIdx.x == 0 && F.tid == 0) { const unsigned long long c_ = __builtin_amdgcn_s_memtime(); F.MISC[60] = (unsigned)c_; F.MISC[61] = (unsigned)(c_ >> 32); }
#endif
        if (F.G == 256) {
            char* al = (char*)lds + RING_OFF;
            float gq = fabsf(P.q_norm_g[F.lane]), gk = fabsf(P.k_norm_g[F.lane]), gb = fmaxf(fmaxf(fabsf(P.rel_bias[F.lane]), fabsf(P.rel_bias[64 + F.lane])), fmaxf(fabsf(P.rel_bias[128 + F.lane]), fabsf(P.rel_bias[192 + F.lane])));
            gq = wave_max(gq); gk = wave_max(gk); gb = wave_max(gb);
            const float bound = 64.f * C2 * gq * gk + 2.f * LOG2E * gb, shift = bound > 100.f ? bound : 0.f;
            dattn::Outs OU{(const bf16*)(P.ws + WS_SG), (bf16*)(P.ws + WS_BR), P.subln_g, compute_lam(P, F.lane)};
            dattn::Seam S; dattn::BlockRef cur = mk_block(P, F.vcu, 0);
#if defined(PROBE_WAITCYC) || defined(PROBE_SEG) || defined(PROBE_BSEG)
            S.wcyc = 0ull;
#endif
            _Pragma("unroll 1") for (int i = 0; i < 4; ++i) {
                if ((i & 1) == 0) {
                    __syncthreads();
                    if (F.tid == 0) *(float*)(al + dattn::L_MISC) = shift;
                    for (int e = F.tid; e < 1024; e += NWAVES * 64) { const int c = e >> 9, jj = e & 511, d = jj - dattn::TAB_OFF;
                        const int dd = d > 113 ? 113 : d;
                        ((float*)(al + dattn::L_TAB))[e] = d < 0 ? -__builtin_inff() : (P.rel_bias[(t5_bucket(dd) * NH + cur.h) * 2 + c] - P.rel_bias[(31 * NH + cur.h) * 2 + c]) * LOG2E - shift; }
                    __syncthreads();
                    if (i == 0) dattn::dattn_issue(cur, al, S);
                }
                const dattn::BlockRef nxt = mk_block(P, F.vcu, i < 3 ? i + 1 : 3); dattn::dattn_block<0>(cur, nxt, i < 3, al, S, OU); cur = nxt; }
            __syncthreads();
#if defined(PROBE_WAITCYC) || defined(PROBE_SEG) || defined(PROBE_BSEG)
            if (blockIdx.x == 0 && F.tid == 0) { F.MISC[58] = (unsigned)S.wcyc; F.MISC[59] = (unsigned)(S.wcyc >> 32); }
#endif
        }
        if (BOTH(2)) xcd_barrier(bar);
    }
#ifdef PROBE_CLK
    if (blockIdx.x == 0 && F.tid == 0) { const unsigned long long c_ = __builtin_amdgcn_s_memtime(); F.MISC[62] = (unsigned)c_; F.MISC[63] = (unsigned)(c_ >> 32); }
#endif
    STAMP(3);
    if (IN(3)) {
        pg8::Gemm g{(const bf16*)(P.ws + WS_BR), (const bf16*)(P.ws + WS_WBR), MROWS, DM, DM}; pg8::StaticOrder S; S.init(MROWS, DM, F.G, (int)blockIdx.x);
        pg8::EpiMerge E{(const bf16*)(P.ws + WS_GATE), (const bf16*)(P.ws + WS_GATE + 64 * MiB), (bf16*)(P.ws + WS_MERGED)
#ifdef PROBE_P3CYC
            , (unsigned long long*)(P.ws + WS_CTL + 1024)
#endif
        };
        pg8::gemm_phase<pg8::EpiMerge, pg8::StaticOrder, true, true>(F.lds + RING_OFF, g, S, E);
        if (BOTH(3)) xcd_barrier(bar);
    }
    STAMP(4);
    if (IN(4)) {
        pg8::Gemm g{(const bf16*)(P.ws + WS_MERGED), (const bf16*)(P.ws + WS_WOUT), MROWS, DM, DM}; pg8::StaticOrder S; S.init(MROWS, DM, F.G, (int)blockIdx.x);
        pg8::EpiOut E{P.x, P.out};
        pg8::gemm_phase<pg8::EpiOut, pg8::StaticOrder, true, true>(F.lds + RING_OFF, g, S, E);
    }
    STAMP(5);
#ifdef PROBE_AMP
    if (blockIdx.x == 0 && F.tid == 0) { LDS_WAIT();
        const unsigned long long ta = ((unsigned long long)F.MISC[17 + 2 * PROBE_AMP] << 32) | F.MISC[16 + 2 * PROBE_AMP], tb = ((unsigned long long)F.MISC[17 + 2 * PROBE_AMP_B] << 32) | F.MISC[16 + 2 * PROBE_AMP_B];
#if defined(PROBE_P3CYC)
        const unsigned long long wc_ = *(volatile unsigned long long*)(P.ws + WS_CTL + 1024);
        const unsigned long long tc0_ = __builtin_amdgcn_s_memtime(); while (__builtin_amdgcn_s_memtime() - tc0_ < 9ull * wc_) __builtin_amdgcn_s_sleep(16);
        const unsigned long long target = rt();
#elif defined(PROBE_WAITCYC) || defined(PROBE_SEG) || defined(PROBE_BSEG)
        const unsigned long long wc_ = ((unsigned long long)F.MISC[59] << 32) | F.MISC[58];
        const unsigned long long tc0_ = __builtin_amdgcn_s_memtime(); while (__builtin_amdgcn_s_memtime() - tc0_ < 9ull * wc_) __builtin_amdgcn_s_sleep(16);
        const unsigned long long target = rt();
#elif defined(PROBE_CLK)
        const unsigned long long c0_ = ((unsigned long long)F.MISC[61] << 32) | F.MISC[60], c1_ = ((unsigned long long)F.MISC[63] << 32) | F.MISC[62];
        const unsigned long long target = rt() + (c1_ - c0_) * 1000ull / (tb - ta);
#else
        const unsigned long long target = rt() + 9ull * (tb - ta);
#endif
        while (rt() < target) __builtin_amdgcn_s_sleep(16); }
#endif
#undef IN
#undef BOTH
}

extern "C" void kernel_launch(void* const* d_in, const int* in_sizes, int n_in, void* d_out, int out_size, void* d_ws, size_t ws_size, hipStream_t stream) {
    static int grid = 0;
    if (grid == 0) {
        if (n_in != 15 || out_size != MROWS * DM || ws_size < WS_END) { fprintf(stderr, "kernel_launch: unexpected shapes n_in %d out %d ws %zu\n", n_in, out_size, ws_size); grid = -1; return; }
        int dev = 0, cus = 0;
        if (hipGetDevice(&dev) != hipSuccess || hipDeviceGetAttribute(&cus, hipDeviceAttributeMultiprocessorCount, dev) != hipSuccess) { grid = -1; return; }
        if (hipFuncSetAttribute((const void*)mega_fwd, hipFuncAttributeMaxDynamicSharedMemorySize, LDS_BYTES) != hipSuccess) { fprintf(stderr, "kernel_launch: hipFuncSetAttribute failed\n"); grid = -1; return; }
        if (cus < 256) { fprintf(stderr, "kernel_launch: needs 256 CUs, device has %d\n", cus); grid = -1; return; }
        grid = 256;
    }
    if (grid < 0) return;
    Ptrs P{};
    P.x = (const float*)d_in[0]; P.meta = (const float*)d_in[1]; P.rel_bias = (const float*)d_in[2]; P.norm_g = (const float*)d_in[3]; P.w_in = (const float*)d_in[4];
    P.q_norm_g = (const float*)d_in[5]; P.k_norm_g = (const float*)d_in[6]; P.lq1 = (const float*)d_in[7]; P.lk1 = (const float*)d_in[8]; P.lq2 = (const float*)d_in[9];
    P.lk2 = (const float*)d_in[10]; P.subln_g = (const float*)d_in[11]; P.conv_w = (const float*)d_in[12]; P.w_branch = (const float*)d_in[13]; P.w_out = (const float*)d_in[14];
    P.out = (float*)d_out; P.ws = (unsigned char*)d_ws;
    if (hipMemsetAsync((char*)d_ws + WS_CTL, 0, CTL_ZERO_BYTES, stream) != hipSuccess) { fprintf(stderr, "kernel_launch: memset failed\n"); return; }
    int li = 0;
#ifdef PROBE_TWICE
    const int seq[2][2] = {{0, 5}, {0, 5}}; const int nseq = 2;
#elif defined(PROBE_REPEAT)
    const int seq[2][2] = {{0, PROBE_REPEAT + 1}, {PROBE_REPEAT, 5}}; const int nseq = 2;
#else
    const int seq[1][2] = {{0, 5}}; const int nseq = 1;
#endif
    for (int s = 0; s < nseq; ++s) {
        Args a{}; a.P = P; a.ph_lo = seq[s][0]; a.ph_hi = seq[s][1]; a.li = li++; a.pad = 0;
        hipLaunchKernelGGL(mega_fwd, dim3(grid), dim3(NWAVES * 64), LDS_BYTES, stream, a);
    }
}
```

```cpp
#include <hip/hip_runtime.h>
#include <cstdio>
#include <cstdint>

constexpr int BATCH = 8, SEQ = 4096, DM = 1024, NMETA = 16, LTOK = NMETA + SEQ  , MROWS = BATCH * SEQ  ;
constexpr int NH = 4, HD = 64, VD = 128, AW = 512, CW = 512, INC = 6144;
constexpr int NKT = 66;
constexpr float EPS = 1e-6f;
constexpr float LOG2E = 1.4426950408889634f;
constexpr float C2 = 0.125f * LOG2E;
constexpr float LAM_INIT = 0.2f;

typedef unsigned short bf16_t;
__device__ __forceinline__ float bf2f(unsigned short h) { return __builtin_bit_cast(float, (unsigned)h << 16); }

constexpr size_t MiB = 1u << 20;
constexpr size_t WS_CTL = 0;
constexpr size_t WS_RS = 1 * MiB;
constexpr size_t WS_WIN = 2 * MiB;
constexpr size_t WS_WBR = 14 * MiB;
constexpr size_t WS_WOUT = 16 * MiB;
constexpr size_t WS_XB = 18 * MiB;
constexpr size_t WS_BR = 405 * MiB;
constexpr size_t WS_Q = 82 * MiB;
constexpr size_t WS_K = 114 * MiB;
constexpr size_t WS_MERGED = WS_XB;
constexpr size_t WS_V = 147 * MiB;
constexpr size_t WS_SG = 180 * MiB;
constexpr size_t WS_U = 212 * MiB;
constexpr size_t WS_GB = 245 * MiB;
constexpr size_t WS_GATE = 277 * MiB;
constexpr size_t WS_END = 469 * MiB;

__host__ __device__ __forceinline__ size_t kimg_off(int b, int h, int c, int pos, int d) {
    const int j = pos >> 6, row = pos & 63, chunk = d >> 3;
    const size_t tile = (size_t)((b * NH + h) * 2 + c) * NKT + j;
    return tile * 4096 + row * 64 + ((chunk ^ ((row >> 1) & 7)) << 3) + (d & 7);
}
__host__ __device__ __forceinline__ size_t vimg_off(int b, int h, int pos, int dv) {
    const int j = pos >> 6, k = pos & 63;
    const int kk = (k & ~0xC) | ((k & 4) << 1) | ((k & 8) >> 1);
    const size_t tile = (size_t)(b * NH + h) * NKT + j;
    return tile * 8192 + ((kk >> 3) * 4 + (dv >> 5)) * 256 + (kk & 7) * 32 + (dv & 31);
}
__device__ __forceinline__ int t5_bucket(int d) {
    if (d < 16) return d;
    int b = 16;
    b += (d >= 19); b += (d >= 21); b += (d >= 24); b += (d >= 27); b += (d >= 31); b += (d >= 35); b += (d >= 40); b += (d >= 46);
    b += (d >= 52); b += (d >= 59); b += (d >= 67); b += (d >= 77); b += (d >= 87); b += (d >= 99); b += (d >= 113);
    return b;
}
__device__ __forceinline__ float wave_sum(float v) {
#pragma unroll
    for (int o = 1; o < 64; o <<= 1) v += __shfl_xor(v, o);
    return v;
}
__device__ __forceinline__ float wave_max(float v) {
#pragma unroll
    for (int o = 1; o < 64; o <<= 1) v = fmaxf(v, __shfl_xor(v, o));
    return v;
}
__device__ __forceinline__ float silu_f(float v) { return v / (1.f + __expf(-v)); }
__device__ __forceinline__ float sigmoid_f(float v) { return 1.f / (1.f + __expf(-v)); }

struct Ptrs {
    const float *x, *meta, *rel_bias, *norm_g, *w_in, *q_norm_g, *k_norm_g, *lq1, *lk1, *lq2, *lk2, *subln_g, *conv_w, *w_branch, *w_out;
    float* out; unsigned char* ws;
};

#define GAS __attribute__((address_space(1)))
#define LAS __attribute__((address_space(3)))
typedef unsigned short bf16;
typedef unsigned v4u __attribute__((ext_vector_type(4)));
typedef float f32x4 __attribute__((ext_vector_type(4)));
typedef short bf16x8 __attribute__((ext_vector_type(8)));
typedef GAS unsigned gu32;
typedef GAS unsigned long long gu64;
#define RLX_AGENT __ATOMIC_RELAXED, __HIP_MEMORY_SCOPE_AGENT
#define LDS_WAIT() asm volatile("s_waitcnt lgkmcnt(0)" ::: "memory")
#define VM_WAIT() asm volatile("s_waitcnt vmcnt(0)" ::: "memory")
__device__ __forceinline__ unsigned long long rt() { return __builtin_amdgcn_s_memrealtime(); }
__device__ __forceinline__ unsigned f2bf(float f) { unsigned u = __builtin_bit_cast(unsigned, f); return (u + 0x7fffu + ((u >> 16) & 1u)) >> 16; }
__device__ __forceinline__ unsigned pk2(float lo, float hi) { return f2bf(lo) | (f2bf(hi) << 16); }

__device__ __forceinline__ float compute_lam(const Ptrs& P, int lane) {
    const float a = wave_sum(P.lq1[lane] * P.lk1[lane]), c = wave_sum(P.lq2[lane] * P.lk2[lane]);
    return __expf(a) - __expf(c) + LAM_INIT;
}
__device__ __forceinline__ float bflo_(unsigned w) { return __builtin_bit_cast(float, w << 16); }
__device__ __forceinline__ float bfhi_(unsigned w) { return __builtin_bit_cast(float, w & 0xffff0000u); }

#define XB_TMO      128
#define XB_XCNT(j)  (256  + 64 * (j))
#define XB_XSUB(j)  (1280 + 64 * (j))
#define XB_XGEN(j)  (2304 + 64 * (j))
#define XB_TOP      3328
#define XB_TOPGEN   3392
#define XCD_BAR_WORDS 3456
#define XB_SPIN_CAP (1u << 18)

__device__ __forceinline__ unsigned xb_ld(unsigned* p)              { return __hip_atomic_load(p, __ATOMIC_RELAXED, __HIP_MEMORY_SCOPE_AGENT); }
__device__ __forceinline__ unsigned xb_add(unsigned* p, unsigned v) { return __hip_atomic_fetch_add(p, v, __ATOMIC_RELAXED, __HIP_MEMORY_SCOPE_AGENT); }
__device__ __forceinline__ unsigned xb_xcc_id() { return (unsigned)__builtin_amdgcn_s_getreg((3 << 11) | 20) & 0xFu; }
#define XB_SPIN(cond, bar) do { unsigned _sp = 0; while (cond) { __builtin_amdgcn_s_sleep(1); \
    if ((++_sp & 255u) == 0u) { if (xb_ld(&(bar)[XB_TMO])) break; if (_sp > XB_SPIN_CAP) { atomicAdd(&(bar)[XB_TMO], 1u); break; } } } } while (0)

struct XcdBarrier {
    unsigned* bar; unsigned x;
    volatile LAS unsigned* st;
};

__device__ __forceinline__ XcdBarrier xcd_barrier_post(unsigned* bar, volatile LAS unsigned* st) {
    XcdBarrier b; b.bar = bar; b.x = xb_xcc_id(); b.st = st;
    if (threadIdx.x == 0) st[2] = xb_add(&bar[XB_XCNT(b.x)], 1u);
    return b;
}
__device__ __forceinline__ void xcd_barrier_complete(unsigned* bar, unsigned x, unsigned& nloc, unsigned& nx, unsigned& even32) {
    const unsigned G = gridDim.x * gridDim.y * gridDim.z;
    unsigned sum, cnt, mine, odd, sp = 0u;
    for (;;) {
        sum = 0u; cnt = 0u; mine = 0u; odd = 0u;
#pragma unroll
        for (unsigned j = 0; j < 16; ++j) { const unsigned c = xb_ld(&bar[XB_XCNT(j)]); sum += c; cnt += (c > 0u) ? 1u : 0u; odd += (j < 8u ? c != 32u : c != 0u) ? 1u : 0u; mine = (j == x) ? c : mine; }
        if (sum == G) break;
        __builtin_amdgcn_s_sleep(1);
        if ((++sp & 255u) == 0u) { if (xb_ld(&bar[XB_TMO])) break; if (sp > XB_SPIN_CAP) { atomicAdd(&bar[XB_TMO], 1u); break; } }
    }
    nloc = mine > 0u ? mine : 1u; nx = cnt > 0u ? cnt : 1u; even32 = (sum == G && G == 256u && cnt == 8u && odd == 0u) ? 1u : 2u;
}

__device__ __forceinline__ void xcd_barrier(const XcdBarrier& b) {
    asm volatile("s_waitcnt vmcnt(0)" ::: "memory");
    __syncthreads();
    if (threadIdx.x == 0) {
        unsigned* bar = b.bar;
        __builtin_amdgcn_s_waitcnt(0);
        unsigned nloc = b.st[0], nx = b.st[1];
        if (nloc == 0u) { unsigned e32; xcd_barrier_complete(bar, b.x, nloc, nx, e32); b.st[0] = nloc; b.st[1] = nx; b.st[3] = e32; }
        const unsigned old = xb_add(&bar[XB_XSUB(b.x)], 1u);
        const unsigned gen = old / nloc;
        if (old + 1u == (gen + 1u) * nloc) {
            __builtin_amdgcn_fence(__ATOMIC_RELEASE, "agent");
            asm volatile("s_waitcnt vmcnt(0)" ::: "memory");
            const unsigned og = xb_add(&bar[XB_TOP], 1u);
            const unsigned tg = og / nx;
            if (og + 1u == (tg + 1u) * nx) xb_add(&bar[XB_TOPGEN], 1u);
            else XB_SPIN(xb_ld(&bar[XB_TOPGEN]) == tg, bar);
            __builtin_amdgcn_fence(__ATOMIC_ACQUIRE, "agent");
            xb_add(&bar[XB_XGEN(b.x)], 1u);
            asm volatile("s_waitcnt vmcnt(0)" ::: "memory");
        } else {
            XB_SPIN(xb_ld(&bar[XB_XGEN(b.x)]) == gen, bar);
            __builtin_amdgcn_fence(__ATOMIC_ACQUIRE, "agent");
            asm volatile("s_waitcnt vmcnt(0)" ::: "memory");
        }
    }
    __syncthreads();
}

__device__ __forceinline__ void xcd_local_barrier(unsigned* tmo_bar, unsigned* lb, unsigned x, const unsigned n = 32u) {
    asm volatile("s_waitcnt vmcnt(0)" ::: "memory");
    __syncthreads();
    if (threadIdx.x == 0) {
        __builtin_amdgcn_s_waitcnt(0);
        const unsigned old = xb_add(&lb[64u * x], 1u);
        const unsigned target = (old / n + 1u) * n;
        XB_SPIN(xb_ld(&lb[64u * x]) < target, tmo_bar);
        __builtin_amdgcn_fence(__ATOMIC_ACQUIRE, "agent");
        asm volatile("s_waitcnt vmcnt(0)" ::: "memory");
    }
    __syncthreads();
}

namespace pg8 {
#define PG8_LAS __attribute__((address_space(3)))
typedef unsigned short bf16_t;
typedef short bf16x8 __attribute__((ext_vector_type(8)));
typedef float f32x4 __attribute__((ext_vector_type(4)));
typedef unsigned u32x4 __attribute__((ext_vector_type(4)));
constexpr int BM = 256, BK = 64, HALF = 128, HTB = HALF * BK * 2  , STAGE_BYTES = 8 * HTB, NXCD = 8, WGM = 8;

__host__ __device__ __forceinline__ int lds_byte(int r, int c) { const int st = (r >> 4) * 2 + (c >> 5), rr = r & 15, cc = c & 31, ob = rr * 64 + cc * 2; return st * 1024 + (ob ^ (((ob >> 9) & 1) << 5)); }
__host__ __device__ __forceinline__ void stage_rc(int b, int& R, int& C) { const int st = b / 1024, sb = b % 1024, swz = sb ^ (((sb >> 9) & 1) << 5); R = (st >> 1) * 16 + swz / 64; C = (st & 1) * 32 + (swz % 64) / 2; }
__host__ __device__ __forceinline__ int perm32(int rho) { const int n = rho >> 4, i = rho & 15; return 8 * (i >> 2) + 4 * n + (i & 3); }

struct Unit { int pm, pn; };
struct Gemm { const bf16_t* A; const bf16_t* Bt; int M, N, K; };

struct StaticOrder {
    int nM, nN, nwg, G, c, rot;
    __host__ __device__ void init(int M, int N, int G_, int c_, int rot_ = 0) { nM = M / BM; nN = N / BM; nwg = nM * nN; G = G_; c = c_; rot = rot_; }
    __host__ __device__ bool next(int i, Unit& u) const {
        const long L = (long)i * G + c; if (L >= nwg) return false;
        int wgid = (int)L; { const int q = nwg / NXCD, r = nwg % NXCD, xcd = wgid % NXCD, off = wgid / NXCD; wgid = (xcd < r ? xcd * (q + 1) : r * (q + 1) + (xcd - r) * q) + off; }
        const int nig = WGM * nN, gid = wgid / nig, fm = gid * WGM, gsz = (nM - fm) < WGM ? (nM - fm) : WGM;
        u.pm = fm + ((wgid % nig) % gsz); u.pn = (wgid % nig) / gsz + ((gid & 1) ? rot : 0); if (u.pn >= nN) u.pn -= nN; return true;
    }
    __device__ __forceinline__ void a_ready(const Unit&) const {}
    __device__ __forceinline__ void done(const Unit&) const {}
};

struct XcdOrder {
    StaticOrder so; int local, xcc, rank;
    __host__ __device__ bool next(int i, Unit& u) const {
        if (!local) return so.next(i, u);
        if (i >= 2) return false;
        if (local == 2) { const int j = rank & 7; u.pm = 16 * xcc + (i == 0 ? j : 15 - j); u.pn = rank >> 3; return true; }
        const int idx = rank + 32 * i; u.pm = 16 * xcc + (idx >> 2); u.pn = idx & 3; return true;
    }
    __device__ __forceinline__ void a_ready(const Unit&) const {}
    __device__ __forceinline__ void done(const Unit&) const {}
};

typedef float f32x2_t __attribute__((ext_vector_type(2))); typedef __bf16 bf16x2_t __attribute__((ext_vector_type(2)));
__device__ __forceinline__ unsigned cvt_pk_bf16(float lo, float hi) { f32x2_t v = {lo, hi}; bf16x2_t b = __builtin_convertvector(v, bf16x2_t); return __builtin_bit_cast(unsigned, b); }
__device__ __forceinline__ float fast_sigmoid(float v) { return __builtin_amdgcn_rcpf(1.f + __builtin_amdgcn_exp2f(-1.4426950408889634f * v)); }
__device__ __forceinline__ float fast_silu(float v) { return v * fast_sigmoid(v); }
__device__ __forceinline__ u32x4 pack8f(const f32x4 a, const f32x4 b) { u32x4 w; w.x = cvt_pk_bf16(a[0], a[1]); w.y = cvt_pk_bf16(a[2], a[3]); w.z = cvt_pk_bf16(b[0], b[1]); w.w = cvt_pk_bf16(b[2], b[3]); return w; }
__device__ __forceinline__ float bflo(unsigned w) { return __builtin_bit_cast(float, w << 16); }
__device__ __forceinline__ float bfhi(unsigned w) { return __builtin_bit_cast(float, w & 0xffff0000u); }

struct EpiProj {
    static constexpr bool PERM = true, AFTER_DRAIN = false, HAS_MID = false, HAS_INIT = false;
    bf16_t *Q, *KI, *VI, *SG, *U, *GB, *RT, *G1, *BRc; const float *qg, *kg, *cw;
    __device__ __forceinline__ void mid(f32x4 (&)[2][2][4][2], const Unit&, int, int, int, int) const {}
    __device__ __forceinline__ void operator()(f32x4 (&acc)[2][2][4][2], const Unit& u, int wr, int wc, int fr, int fq) const {
        const int b = u.pm >> 4, s0 = (u.pm & 15) * 256, pn = u.pn; int rl0 = wr * 64 + fr; asm volatile("" : "+v"(rl0)); asm volatile("" : "+v"(fq));
        if (pn < 4) {
            const bool isq = pn < 2; const float* gp = isq ? qg : kg;
            f32x4 gv[2][2];
#pragma unroll
            for (int bj = 0; bj < 2; ++bj)
#pragma unroll
                for (int n = 0; n < 2; ++n) gv[bj][n] = *(const f32x4*)(gp + 32 * bj + 8 * fq + 4 * n);
            const int grp = (pn & 1) * 4 + wc;
#pragma unroll
            for (int ai = 0; ai < 2; ++ai)
#pragma unroll
                for (int m = 0; m < 4; ++m) {
                    float ss = 0.f;
#pragma unroll
                    for (int bj = 0; bj < 2; ++bj)
#pragma unroll
                        for (int n = 0; n < 2; ++n) { const f32x4 x = acc[ai][bj][m][n]; ss += (x[0] * x[0] + x[1] * x[1]) + (x[2] * x[2] + x[3] * x[3]); }
                    ss += __shfl_xor(ss, 16); ss += __shfl_xor(ss, 32);
                    const float sc = rsqrtf(ss * (1.f / 64.f) + EPS) * (isq ? C2 : 1.f);
                    const int rl = rl0 + 128 * ai + 16 * m;
#pragma unroll
                    for (int bj = 0; bj < 2; ++bj) {
                        const u32x4 w = pack8f(acc[ai][bj][m][0] * sc * gv[bj][0], acc[ai][bj][m][1] * sc * gv[bj][1]);
                        if (isq) *(u32x4*)(Q + (size_t)(u.pm * 256 + rl) * AW + grp * 64 + 32 * bj + 8 * fq) = w;
                        else *(u32x4*)(KI + kimg_off(b, grp >> 1, grp & 1, s0 + rl + NMETA, 32 * bj + 8 * fq)) = w;
                    }
                }
        } else if (pn < 6) {
#pragma unroll
            for (int ai = 0; ai < 2; ++ai)
#pragma unroll
                for (int m = 0; m < 4; ++m) { const int rl = rl0 + 128 * ai + 16 * m;
#pragma unroll
                    for (int bj = 0; bj < 2; ++bj)
                        *(u32x4*)(VI + vimg_off(b, (pn - 4) * 2 + bj, s0 + rl + NMETA, 32 * wc + 8 * fq)) = pack8f(acc[ai][bj][m][0], acc[ai][bj][m][1]);
                }
        } else if (pn < 8) {
#pragma unroll
            for (int ai = 0; ai < 2; ++ai)
#pragma unroll
                for (int m = 0; m < 4; ++m) { const int rl = rl0 + 128 * ai + 16 * m;
#pragma unroll
                    for (int bj = 0; bj < 2; ++bj) { f32x4 a = acc[ai][bj][m][0], c = acc[ai][bj][m][1];
#pragma unroll
                        for (int i = 0; i < 4; ++i) { a[i] = fast_silu(a[i]); c[i] = fast_silu(c[i]); }
                        *(u32x4*)(SG + (size_t)(u.pm * 256 + rl) * AW + (pn - 6) * 256 + 128 * bj + 32 * wc + 8 * fq) = pack8f(a, c); }
                }
        } else if (pn < 16) {
            const int ch0 = 64 * (pn - 8) + 16 * wc + 4 * fq;
            const f32x4 w0 = *(const f32x4*)(cw + ch0), w1 = *(const f32x4*)(cw + CW + ch0), w2 = *(const f32x4*)(cw + 2 * CW + ch0);
#pragma unroll
            for (int ai = 0; ai < 2; ++ai) {
                f32x4 uu[4];
#pragma unroll
                for (int m = 0; m < 4; ++m) uu[m] = acc[ai][0][m][0] * acc[ai][0][m][1];
#pragma unroll
                for (int m = 0; m < 4; ++m) { const int rl = rl0 + 128 * ai + 16 * m;
                    f32x4 g = acc[ai][1][m][1];
#pragma unroll
                    for (int i = 0; i < 4; ++i) g[i] = fast_silu(g[i]);
                    const f32x4 gb = acc[ai][1][m][0] * g;
                    f32x4 u1, u2;
#pragma unroll
                    for (int i = 0; i < 4; ++i) {
                        const float pv_ = uu[m > 0 ? m - 1 : 0][i], cu_ = uu[m][i];
                        const int ln = threadIdx.x & 63;
                        #define DPPF(v, ctrl) __builtin_bit_cast(float, __builtin_amdgcn_update_dpp(0, __builtin_bit_cast(int, v), ctrl, 0xF, 0xF, true))
#define DPPO(o, v, ctrl) __builtin_bit_cast(float, __builtin_amdgcn_update_dpp(__builtin_bit_cast(int, o), __builtin_bit_cast(int, v), ctrl, 0xF, 0xF, false))
                        const float b1 = DPPF(pv_, 0x121), b2 = DPPF(pv_, 0x122);
                        u1[i] = DPPO(b1, cu_, 0x111); u2[i] = DPPO(b2, cu_, 0x112);
#undef DPPF
#undef DPPO
                    }
                    const f32x4 cv = gb * (w0 * u2 + w1 * u1 + w2 * uu[m]);
                    const int r64 = 16 * m + fr;
                    if (r64 >= 2) { uint2 wc_; wc_.x = cvt_pk_bf16(cv[0], cv[1]); wc_.y = cvt_pk_bf16(cv[2], cv[3]); typedef unsigned u32x2_t __attribute__((ext_vector_type(2))); __builtin_nontemporal_store((u32x2_t){wc_.x, wc_.y}, (u32x2_t*)(BRc + (size_t)(u.pm * 256 + rl) * 1024 + 512 + ch0)); }
                    if (r64 < 2 || r64 >= 62) { uint2 wu; wu.x = cvt_pk_bf16(uu[m][0], uu[m][1]); wu.y = cvt_pk_bf16(uu[m][2], uu[m][3]); *(uint2*)(U + ((size_t)b * LTOK + s0 + rl + NMETA) * CW + ch0) = wu; }
                    if (r64 < 2) { uint2 wg; wg.x = cvt_pk_bf16(gb[0], gb[1]); wg.y = cvt_pk_bf16(gb[2], gb[3]); *(uint2*)(GB + (size_t)(u.pm * 256 + rl) * CW + ch0) = wg; }
                }
            }
        } else {
            const int j0 = 128 * (pn - 16) + 32 * wc + 8 * fq;
#pragma unroll
            for (int ai = 0; ai < 2; ++ai)
#pragma unroll
                for (int m = 0; m < 4; ++m) { const int rl = rl0 + 128 * ai + 16 * m;
                    f32x4 rt[2], s1[2];
#pragma unroll
                    for (int n = 0; n < 2; ++n)
#pragma unroll
                        for (int i = 0; i < 4; ++i) {
                            const float e0 = __builtin_amdgcn_exp2f(fminf(-1.4426950408889634f * acc[ai][0][m][n][i], 60.f)), e1 = __builtin_amdgcn_exp2f(fminf(-1.4426950408889634f * acc[ai][1][m][n][i], 60.f));
                            rt[n][i] = (1.f + e1) * __builtin_amdgcn_rcpf(1.f + e0); s1[n][i] = __builtin_amdgcn_rcpf(1.f + e1); }
                    __builtin_nontemporal_store(pack8f(rt[0], rt[1]), (u32x4*)(RT + (size_t)(u.pm * 256 + rl) * DM + j0));
                    __builtin_nontemporal_store(pack8f(s1[0], s1[1]), (u32x4*)(G1 + (size_t)(u.pm * 256 + rl) * DM + j0));
                }
        }
    }
};

struct EpiMerge {
    static constexpr bool PERM = true, AFTER_DRAIN = false, HAS_MID = true, HAS_INIT = false;
    const bf16_t* RT; const bf16_t* G1; bf16_t* MG;
#ifdef PROBE_P3CYC
    unsigned long long* wc;
#endif
    __device__ __forceinline__ void scale(f32x4 (&acc)[2][2][4][2], const bf16_t* G, const Unit& u, int wr, int wc, int fr, int fq) const {
        u32x4 gv[2][4][2];
#pragma unroll
        for (int ai = 0; ai < 2; ++ai)
#pragma unroll
            for (int m = 0; m < 4; ++m) { const size_t row = (size_t)u.pm * 256 + 128 * ai + 64 * wr + 16 * m + fr;
#pragma unroll
                for (int bj = 0; bj < 2; ++bj) gv[ai][m][bj] = __builtin_nontemporal_load((const u32x4*)(G + row * DM + u.pn * 256 + 128 * bj + 32 * wc + 8 * fq)); }
#pragma unroll
        for (int ai = 0; ai < 2; ++ai)
#pragma unroll
            for (int m = 0; m < 4; ++m)
#pragma unroll
                for (int bj = 0; bj < 2; ++bj) { const u32x4 a = gv[ai][m][bj];
                    acc[ai][bj][m][0] *= (f32x4){bflo(a.x), bfhi(a.x), bflo(a.y), bfhi(a.y)}; acc[ai][bj][m][1] *= (f32x4){bflo(a.z), bfhi(a.z), bflo(a.w), bfhi(a.w)}; }
    }
    __device__ __forceinline__ void mid(f32x4 (&acc)[2][2][4][2], const Unit& u, int wr, int wc, int fr, int fq) const {
        asm volatile("" : "+v"(fr)); asm volatile("" : "+v"(fq));
#ifdef PROBE_P3CYC
        const unsigned long long t0_ = __builtin_amdgcn_s_memtime();
#endif
        scale(acc, RT, u, wr, wc, fr, fq);
#ifdef PROBE_P3CYC
        asm volatile("" : "+v"(acc[0][0][0][0])); if (blockIdx.x == 0 && threadIdx.x == 0) *this->wc += __builtin_amdgcn_s_memtime() - t0_;
#endif
    }
    __device__ __forceinline__ void operator()(f32x4 (&acc)[2][2][4][2], const Unit& u, int wr, int wc, int fr, int fq) const {
        asm volatile("" : "+v"(fr)); asm volatile("" : "+v"(fq));
        scale(acc, G1, u, wr, wc, fr, fq);
#pragma unroll
        for (int ai = 0; ai < 2; ++ai)
#pragma unroll
            for (int m = 0; m < 4; ++m) { const size_t row = (size_t)u.pm * 256 + 128 * ai + 64 * wr + 16 * m + fr;
#pragma unroll
                for (int bj = 0; bj < 2; ++bj) *(u32x4*)(MG + row * DM + u.pn * 256 + 128 * bj + 32 * wc + 8 * fq) = pack8f(acc[ai][bj][m][0], acc[ai][bj][m][1]); }
    }
};

struct EpiOut {
    static constexpr bool PERM = false, AFTER_DRAIN = false, HAS_MID = false, HAS_INIT = true;
    const float* x; float* out;
    __device__ __forceinline__ void mid(f32x4 (&)[2][2][4][2], const Unit&, int, int, int, int) const {}
    __device__ __forceinline__ void init(f32x4 (&acc)[2][2][4][2], const Unit& u, int wr, int wc, int fr, int fq) const {
        asm volatile("" : "+v"(fr)); asm volatile("" : "+v"(fq));
#pragma unroll
        for (int ai = 0; ai < 2; ++ai)
#pragma unroll
            for (int m = 0; m < 4; ++m) { const size_t off = ((size_t)u.pm * 256 + 128 * ai + 64 * wr + 16 * m + fr) * DM + u.pn * 256 + 32 * wc + 4 * fq;
#pragma unroll
                for (int bj = 0; bj < 2; ++bj)
#pragma unroll
                    for (int n = 0; n < 2; ++n) acc[ai][bj][m][n] = __builtin_nontemporal_load((const f32x4*)(x + off + bj * HALF + n * 16)); }
    }
    __device__ __forceinline__ void operator()(f32x4 (&acc)[2][2][4][2], const Unit& u, int wr, int wc, int fr, int fq) const {
        asm volatile("" : "+v"(fr)); asm volatile("" : "+v"(fq));
#pragma unroll
        for (int ai = 0; ai < 2; ++ai)
#pragma unroll
            for (int m = 0; m < 4; ++m) { const size_t off = ((size_t)u.pm * 256 + 128 * ai + 64 * wr + 16 * m + fr) * DM + u.pn * 256 + 32 * wc + 4 * fq;
#pragma unroll
                for (int bj = 0; bj < 2; ++bj)
#pragma unroll
                    for (int n = 0; n < 2; ++n) *(f32x4*)(out + off + bj * HALF + n * 16) = acc[ai][bj][m][n]; }
    }
};

template <class Epi, class Sched, bool ALIGN_EPI = false, bool SP2 = false>
__device__ __forceinline__ void gemm_phase(PG8_LAS unsigned char* lds, const Gemm g, const Sched& S, const Epi& E) {
    const int tid = threadIdx.x, wid = __builtin_amdgcn_readfirstlane(tid >> 6), lane = tid & 63, wr = wid >> 2, wc = wid & 3, fr = lane & 15, fq = lane >> 4;
    const int K = g.K, nt = K / BK;
    unsigned voffA[2], voffB[2];
#pragma unroll
    for (int i = 0; i < 2; ++i) { int R, C; stage_rc(tid * 16 + i * 8192, R, C); const int Rb = Epi::PERM ? ((R & ~31) + perm32(R & 31)) : R;
        voffA[i] = (unsigned)(R * K + C) * 2u; voffB[i] = (unsigned)(Rb * K + C) * 2u; }
    const size_t kstep = (size_t)(BK * 2);
    const size_t hstep = (size_t)HALF * K * 2;
    const size_t tstep = 2 * hstep;
    const unsigned ldsw = (unsigned)wid * 1024u;
    const int aoff = lds_byte(wr * 64 + fr, fq * 8), boff = lds_byte(wc * 32 + fr, fq * 8);
#define PG8_SA(b, h) (((b) * 2 + (h)) * HTB)
#define PG8_SB(b, h) ((4 + (b) * 2 + (h)) * HTB)
#define PG8_STAGE(bufoff, gbase, voff) do { _Pragma("unroll") for (int _i = 0; _i < 2; ++_i) \
        __builtin_amdgcn_global_load_lds((const unsigned*)((const char*)(gbase) + (voff)[_i]), (PG8_LAS unsigned*)(lds + (bufoff) + ldsw + _i * 8192), 16, 0, 0); } while (0)
#define PG8_LDA(dst, b, h) do { _Pragma("unroll") for (int m = 0; m < 4; ++m) _Pragma("unroll") for (int k = 0; k < 2; ++k) dst[m][k] = *(const PG8_LAS bf16x8*)(lds + PG8_SA(b, h) + aoff + m * 2048 + k * 1024); } while (0)
#define PG8_LDB(dst, b, h) do { _Pragma("unroll") for (int n = 0; n < 2; ++n) _Pragma("unroll") for (int k = 0; k < 2; ++k) dst[n][k] = *(const PG8_LAS bf16x8*)(lds + PG8_SB(b, h) + boff + n * 2048 + k * 1024); } while (0)
#define PG8_MMA(ai, bj, At, Bt) do { __builtin_amdgcn_s_setprio(1); _Pragma("unroll") for (int m = 0; m < 4; ++m) _Pragma("unroll") for (int n = 0; n < 2; ++n) _Pragma("unroll") for (int k = 0; k < 2; ++k) \
        acc[ai][bj][m][n] = __builtin_amdgcn_mfma_f32_16x16x32_bf16(Bt[n][k], At[m][k], acc[ai][bj][m][n], 0, 0, 0); __builtin_amdgcn_s_setprio(0); } while (0)
#define PG8_WAIT_V(n) asm volatile("s_waitcnt vmcnt(" #n ")" ::: "memory")
#define PG8_WAIT_L(n) asm volatile("s_waitcnt lgkmcnt(" #n ")" ::: "memory")
#define PG8_BAR __builtin_amdgcn_s_barrier()
#define PG8_SCHED __builtin_amdgcn_sched_barrier(0)
    Unit cur, nxt; int ui = 0;
    if (!S.next(0, cur)) return;
    f32x4 acc[2][2][4][2];
#pragma unroll
    for (int a = 0; a < 2; ++a)
#pragma unroll
        for (int b = 0; b < 2; ++b)
#pragma unroll
            for (int m = 0; m < 4; ++m)
#pragma unroll
                for (int n = 0; n < 2; ++n) acc[a][b][m][n] = (f32x4){0.f, 0.f, 0.f, 0.f};
    if constexpr (Epi::HAS_INIT) E.init(acc, cur, wr, wc, fr, fq);
    bf16x8 At[4][2], B0[2][2], B1[2][2];
    const char* cA = (const char*)g.A + (size_t)cur.pm * tstep; const char* cB = (const char*)g.Bt + (size_t)cur.pn * tstep;
    S.a_ready(cur);
    if constexpr (SP2) {
        PG8_STAGE(PG8_SB(0, 0), cB, voffB); PG8_STAGE(PG8_SB(0, 1), cB + hstep, voffB); PG8_STAGE(PG8_SA(0, 0), cA, voffA); PG8_STAGE(PG8_SA(0, 1), cA + hstep, voffA);
        if (wr == 1) PG8_BAR;
        PG8_WAIT_V(2); PG8_BAR;
        PG8_STAGE(PG8_SB(1, 0), cB + kstep, voffB); PG8_STAGE(PG8_SA(1, 0), cA + kstep, voffA); PG8_STAGE(PG8_SB(1, 1), cB + hstep + kstep, voffB);
        PG8_WAIT_V(6); PG8_BAR;
    } else {
        PG8_STAGE(PG8_SB(0, 0), cB, voffB); PG8_STAGE(PG8_SA(0, 0), cA, voffA); PG8_STAGE(PG8_SB(0, 1), cB + hstep, voffB); PG8_STAGE(PG8_SA(0, 1), cA + hstep, voffA);
        if (wr == 1) PG8_BAR;
        PG8_WAIT_V(4); PG8_BAR;
        PG8_STAGE(PG8_SB(1, 0), cB + kstep, voffB); PG8_STAGE(PG8_SA(1, 0), cA + kstep, voffA); PG8_STAGE(PG8_SB(1, 1), cB + hstep + kstep, voffB);
        PG8_WAIT_V(6); PG8_BAR;
    }
    for (;;) {
        const bool has_next = S.next(ui + 1, nxt);
        const char* nA = has_next ? (const char*)g.A + (size_t)nxt.pm * tstep : cA; const char* nB = has_next ? (const char*)g.Bt + (size_t)nxt.pn * tstep : cB;
        for (int t = 0; t < nt; t += 2) {
            if constexpr (Epi::HAS_MID) { if (t == nt / 2) E.mid(acc, cur, wr, wc, fr, fq); }
            const bool last = (t == nt - 2);
            const char* a1 = cA + (size_t)(t + 1) * kstep;
            const char* a2 = last ? nA : cA + (size_t)(t + 2) * kstep; const char* b2 = last ? nB : cB + (size_t)(t + 2) * kstep;
            const char* a3 = a2 + kstep; const char* b3 = b2 + kstep;
            if (last && has_next) S.a_ready(nxt);
            if constexpr (SP2) {
            PG8_LDB(B0, 0, 0); PG8_LDB(B1, 0, 1); PG8_SCHED; PG8_LDA(At, 0, 0); PG8_STAGE(PG8_SA(1, 1), a1 + hstep, voffA);
            PG8_WAIT_V(8); PG8_WAIT_L(0); PG8_BAR; PG8_MMA(0, 0, At, B0); PG8_MMA(0, 1, At, B1); PG8_BAR; PG8_SCHED;
            PG8_LDA(At, 0, 1); PG8_STAGE(PG8_SB(0, 0), b2, voffB); PG8_STAGE(PG8_SB(0, 1), b2 + hstep, voffB); PG8_STAGE(PG8_SA(0, 0), a2, voffA);
            PG8_WAIT_V(8); PG8_WAIT_L(0); PG8_BAR; PG8_MMA(1, 0, At, B0); PG8_MMA(1, 1, At, B1); PG8_BAR; PG8_SCHED;
            PG8_LDB(B0, 1, 0); PG8_LDB(B1, 1, 1); PG8_SCHED; PG8_LDA(At, 1, 0); PG8_STAGE(PG8_SA(0, 1), a2 + hstep, voffA);
            PG8_WAIT_V(8); PG8_WAIT_L(0); PG8_BAR; PG8_MMA(0, 0, At, B0); PG8_MMA(0, 1, At, B1); PG8_BAR; PG8_SCHED;
            PG8_LDA(At, 1, 1); PG8_STAGE(PG8_SB(1, 0), b3, voffB); PG8_STAGE(PG8_SB(1, 1), b3 + hstep, voffB); PG8_STAGE(PG8_SA(1, 0), a3, voffA);
            PG8_WAIT_V(8); PG8_WAIT_L(0); PG8_BAR; PG8_MMA(1, 0, At, B0); PG8_MMA(1, 1, At, B1); PG8_BAR; PG8_SCHED;
            } else {
            PG8_LDB(B0, 0, 0); PG8_SCHED; PG8_LDA(At, 0, 0); PG8_STAGE(PG8_SA(1, 1), a1 + hstep, voffA);
            PG8_WAIT_L(8); PG8_BAR; PG8_WAIT_L(0); PG8_MMA(0, 0, At, B0); PG8_BAR; PG8_SCHED;
            PG8_LDB(B1, 0, 1); PG8_STAGE(PG8_SB(0, 0), b2, voffB);
            PG8_BAR; PG8_WAIT_L(0); PG8_MMA(0, 1, At, B1); PG8_BAR;
            PG8_LDA(At, 0, 1); PG8_STAGE(PG8_SA(0, 0), a2, voffA);
            PG8_BAR; PG8_WAIT_L(0); PG8_MMA(1, 0, At, B0); PG8_BAR; PG8_SCHED;
            PG8_STAGE(PG8_SB(0, 1), b2 + hstep, voffB);
            PG8_WAIT_V(6); PG8_BAR; PG8_MMA(1, 1, At, B1); PG8_BAR;
            PG8_LDB(B0, 1, 0); PG8_SCHED; PG8_LDA(At, 1, 0); PG8_STAGE(PG8_SA(0, 1), a2 + hstep, voffA);
            PG8_WAIT_L(8); PG8_BAR; PG8_WAIT_L(0); PG8_MMA(0, 0, At, B0); PG8_BAR; PG8_SCHED;
            PG8_LDB(B1, 1, 1); PG8_STAGE(PG8_SB(1, 0), b3, voffB);
            PG8_BAR; PG8_WAIT_L(0); PG8_MMA(0, 1, At, B1); PG8_BAR;
            PG8_LDA(At, 1, 1); PG8_STAGE(PG8_SA(1, 0), a3, voffA);
            PG8_BAR; PG8_WAIT_L(0); PG8_MMA(1, 0, At, B0); PG8_BAR; PG8_SCHED;
            PG8_STAGE(PG8_SB(1, 1), b3 + hstep, voffB);
            PG8_WAIT_V(6); PG8_BAR; PG8_MMA(1, 1, At, B1); PG8_BAR;
            }
        }
        if constexpr (ALIGN_EPI) { if (wr == 0) PG8_BAR; }
        if constexpr (!Epi::AFTER_DRAIN) { E(acc, cur, wr, wc, fr, fq); S.done(cur); }
        if (!has_next) break;
#pragma unroll
        for (int a = 0; a < 2; ++a)
#pragma unroll
            for (int b = 0; b < 2; ++b)
#pragma unroll
                for (int m = 0; m < 4; ++m)
#pragma unroll
                    for (int n = 0; n < 2; ++n) acc[a][b][m][n] = (f32x4){0.f, 0.f, 0.f, 0.f};
        if constexpr (Epi::HAS_INIT) E.init(acc, nxt, wr, wc, fr, fq);
        cur = nxt; cA = nA; cB = nB; ++ui;
        if constexpr (ALIGN_EPI) { if (wr == 1) PG8_BAR; }
    }
    PG8_WAIT_V(0);
    if constexpr (!ALIGN_EPI) { if (wr == 0) PG8_BAR; }
    PG8_BAR;
    static_assert(!Epi::AFTER_DRAIN, "no after-drain epilogues in this kernel");
#undef PG8_SA
#undef PG8_SB
#undef PG8_STAGE
#undef PG8_LDA
#undef PG8_LDB
#undef PG8_MMA
#undef PG8_WAIT_V
#undef PG8_WAIT_L
#undef PG8_BAR
#undef PG8_SCHED
}
}

namespace dattn {
using bf16x8 = __attribute__((ext_vector_type(8))) short;
using s16x4 = __attribute__((ext_vector_type(4))) short;
using f32x16 = __attribute__((ext_vector_type(16))) float;
using f32x4 = __attribute__((ext_vector_type(4))) float;
using u32x4 = __attribute__((ext_vector_type(4))) unsigned;
constexpr int NW = 8, QBLK = 32, KVBLK = 64, QB = 256;
constexpr int SHM_V = 16384, SHM_K = 8192;
constexpr int NSLOT = 3;
constexpr int L_V = 0, L_K = NSLOT * SHM_V, L_WS = L_K + NSLOT * SHM_K, L_TAB = L_WS + NW * 256, L_O0 = L_TAB + 2 * 2048, L_MISC = L_O0 + NW * 8192, L_END = L_MISC + 1024;
constexpr int TAB_OFF = 304;
constexpr float THR = 8.f;
#define SBAR() __builtin_amdgcn_sched_barrier(0)
__device__ __forceinline__ int v_rd_base(int lane) { return ((lane & 3) << 3) | (((lane >> 2) & 3) << 6) | (((lane >> 4) & 1) << 5) | (((lane >> 5) & 1) << 11); }
constexpr int v_rd_off(int d0, int ks, int half) { return d0 * 512 + ks * 4096 + half * 256; }
__device__ __forceinline__ int crow(int r, int hi) { return (r & 3) + 8 * (r >> 2) + 4 * hi; }
__device__ __forceinline__ unsigned cvtpk(float lo, float hi) { return pg8::cvt_pk_bf16(lo, hi); }

__device__ __forceinline__ void startSM(f32x16& p0, f32x16& p1, bool near, const char* tabp, float shift) {
    if (near) {
#pragma unroll
        for (int r = 0; r < 16; ++r) { const int c = (r & 3) + 8 * (r >> 2);
            p0[r] += *(const float*)(tabp + 4 * (59 - c)); p1[r] += *(const float*)(tabp + 4 * (59 - c - 32)); }
    }
#if 1
    else if (__builtin_expect(shift != 0.f, 0)) {
#pragma unroll
        for (int r = 0; r < 16; ++r) { p0[r] -= shift; p1[r] -= shift; }
    }
#endif
#pragma unroll
    for (int r = 0; r < 16; ++r) p0[r] = __builtin_amdgcn_exp2f(p0[r]);
}
template <bool EXP1>
__device__ __forceinline__ void finishSM(f32x16& p0, f32x16& p1, float& l_reg, bf16x8& pa0, bf16x8& pa1, bf16x8& pa2, bf16x8& pa3) {
    if constexpr (EXP1) {
#pragma unroll
        for (int r = 0; r < 16; ++r) p1[r] = __builtin_amdgcn_exp2f(p1[r]); }
    float ps = 0;
#pragma unroll
    for (int r = 0; r < 16; ++r) ps += p0[r];
#pragma unroll
    for (int r = 0; r < 16; ++r) ps += p1[r];
    l_reg += ps;
#define PK4(P, B_, OUT) do { unsigned a0 = cvtpk(P[B_+0], P[B_+1]), a1 = cvtpk(P[B_+2], P[B_+3]);                          \
        unsigned b0 = cvtpk(P[B_+4], P[B_+5]), b1 = cvtpk(P[B_+6], P[B_+7]);                                             \
        u32x4 w = {a0, a1, b0, b1}; OUT = *reinterpret_cast<bf16x8*>(&w); } while (0)
    PK4(p0, 0, pa0); PK4(p0, 8, pa1); PK4(p1, 0, pa2); PK4(p1, 8, pa3);
#undef PK4
}
__device__ __forceinline__ void qkt(int kslot, f32x16& p0, f32x16& p1, const char* K_lds, int r32, int hi, const bf16x8* qr) {
    p0 = f32x16{}; p1 = f32x16{};
    const int sw = (r32 >> 1) & 7;
#pragma unroll
    for (int d0 = 0; d0 < 4; ++d0) { const char* a = K_lds + kslot + r32 * 128 + (((2 * d0 + hi) ^ sw) << 4);
        bf16x8 b0 = *reinterpret_cast<const bf16x8*>(a);
        bf16x8 b1 = *reinterpret_cast<const bf16x8*>(a + 32 * 128);
        p0 = __builtin_amdgcn_mfma_f32_32x32x16_bf16(b0, qr[d0], p0, 0, 0, 0);
        p1 = __builtin_amdgcn_mfma_f32_32x32x16_bf16(b1, qr[d0], p1, 0, 0, 0); }
}
__device__ __forceinline__ void pv_tile(f32x16* o, int vb0  , bf16x8 pa0, bf16x8 pa1, bf16x8 pa2, bf16x8 pa3) {
#define TRRD(dst, off) asm volatile("ds_read_b64_tr_b16 %0, %1 offset:%2" : "=&v"(dst) : "v"(vb0), "i"(off) : "memory")
#define PV_D0(d0) do { s16x4 l0, l1, l2, l3, h0, h1, h2, h3; constexpr int b_ = v_rd_off(d0, 0, 0);     \
        TRRD(l0, b_); TRRD(h0, b_ + 256); TRRD(l1, b_ + 4096); TRRD(h1, b_ + 4352); TRRD(l2, b_ + 8192); TRRD(h2, b_ + 8448); TRRD(l3, b_ + 12288); TRRD(h3, b_ + 12544); \
        asm volatile("s_waitcnt lgkmcnt(0)" ::: "memory"); SBAR();                                                                                    \
        o[d0] = __builtin_amdgcn_mfma_f32_32x32x16_bf16(pa0, (bf16x8){l0[0], l0[1], l0[2], l0[3], h0[0], h0[1], h0[2], h0[3]}, o[d0], 0, 0, 0);   \
        o[d0] = __builtin_amdgcn_mfma_f32_32x32x16_bf16(pa1, (bf16x8){l1[0], l1[1], l1[2], l1[3], h1[0], h1[1], h1[2], h1[3]}, o[d0], 0, 0, 0);   \
        o[d0] = __builtin_amdgcn_mfma_f32_32x32x16_bf16(pa2, (bf16x8){l2[0], l2[1], l2[2], l2[3], h2[0], h2[1], h2[2], h2[3]}, o[d0], 0, 0, 0);   \
        o[d0] = __builtin_amdgcn_mfma_f32_32x32x16_bf16(pa3, (bf16x8){l3[0], l3[1], l3[2], l3[3], h3[0], h3[1], h3[2], h3[3]}, o[d0], 0, 0, 0); } while (0)
    PV_D0(0); PV_D0(1); PV_D0(2); PV_D0(3);
#undef PV_D0
#undef TRRD
}

typedef __attribute__((address_space(3))) const char* lds_cptr;
typedef short v4i16_t __attribute__((ext_vector_type(4)));
__device__ __forceinline__ s16x4 vtr(lds_cptr p) { return __builtin_bit_cast(s16x4, __builtin_amdgcn_ds_read_tr16_b64_v4i16((__attribute__((address_space(3))) v4i16_t*)p)); }
__device__ __forceinline__ void glds16(const void* gsrc, unsigned lds_dst) { unsigned keep;
    asm volatile("s_mov_b32 %0, m0\n\ts_mov_b32 m0, %2\n\ts_nop 0\n\tglobal_load_lds_dwordx4 %1, off\n\ts_mov_b32 m0, %0" : "=&s"(keep) : "v"(gsrc), "s"(lds_dst) : "memory"); }
template <int VAR>
__device__ __forceinline__ void step(f32x16& x0, f32x16& x1, f32x16& y0, f32x16& y1, float& l_reg, f32x16* o, const bf16x8* qr,
                                     const char* Kc  , int sw, int hi, lds_cptr vb  ,
                                     bool near, const char* tabp, float shift,
                                     bool dk, const char* gk, unsigned lk, bool dv, const char* gv, unsigned lv  ,
                                     bf16x8 (&kp)[4]  , const char* Kn  , bool pre, int wv  ) {
    bf16x8 ka[4], kb[4], pa0, pa1, pa2, pa3;
    s16x4 lo[4], hv[4];
    unsigned a0, a1, b0, b1;
#define KRD(d0) do { if constexpr (VAR & 4) break; const char* a_ = Kc + (((2 * (d0) + hi) ^ sw) << 4); ka[d0] = *reinterpret_cast<const bf16x8*>(a_); kb[d0] = *reinterpret_cast<const bf16x8*>(a_ + 32 * 128); } while (0)
#define VRD(i) do { if constexpr (VAR & 2) break; lo[(i) & 3] = vtr(vb + v_rd_off((i) >> 2, (i) & 3, 0)); hv[(i) & 3] = vtr(vb + v_rd_off((i) >> 2, (i) & 3, 1)); } while (0)
#define VFR(i) (bf16x8){lo[(i) & 3][0], lo[(i) & 3][1], lo[(i) & 3][2], lo[(i) & 3][3], hv[(i) & 3][0], hv[(i) & 3][1], hv[(i) & 3][2], hv[(i) & 3][3]}
#define SUM4(Y, b) do { if constexpr (!(VAR & 8)) { ps += (Y[b] + Y[(b) + 1]) + (Y[(b) + 2] + Y[(b) + 3]); asm volatile("" : "+v"(ps)); } } while (0)
#define PKA(Y, b) do { if constexpr (!(VAR & 8)) { a0 = cvtpk(Y[b], Y[(b) + 1]); a1 = cvtpk(Y[(b) + 2], Y[(b) + 3]); } } while (0)
#define PKB(Y, b, OUT) do { if constexpr (VAR & 8) { OUT = ka[0]; asm volatile("" : "+v"(OUT)); } else { b0 = cvtpk(Y[b], Y[(b) + 1]); b1 = cvtpk(Y[(b) + 2], Y[(b) + 3]); u32x4 w_ = {a0, a1, b0, b1}; OUT = *reinterpret_cast<bf16x8*>(&w_); asm volatile("" : "+v"(OUT)); } } while (0)
#define QKM(X, KF, QF, C) do { if constexpr (VAR & 4) { X = C; asm volatile("" : "+v"(X)); } else X = __builtin_amdgcn_mfma_f32_32x32x16_bf16(KF, QF, C, 0, 0, 0); } while (0)
    float ps = 0.f;
    if constexpr (VAR & 4) { ka[0] = qr[0]; ka[1] = qr[1]; ka[2] = qr[2]; ka[3] = qr[3]; kb[0] = qr[0]; kb[1] = qr[1]; kb[2] = qr[2]; kb[3] = qr[3]; }
    ka[0] = kp[0]; kb[0] = kp[1]; ka[1] = kp[2]; kb[1] = kp[3]; if (dk) glds16(gk, lk); SBAR();
    { const f32x16 z = f32x16{};
      QKM(x0, ka[0], qr[0], z);  SUM4(y0, 0); PKA(y0, 0);       SBAR();
      QKM(x1, kb[0], qr[0], z);  SUM4(y0, 4); PKB(y0, 4, pa0);  KRD(2); if (dv) glds16(gv, lv); SBAR(); }
    QKM(x0, ka[1], qr[1], x0); SUM4(y0, 8); PKA(y0, 8);       SBAR();
    QKM(x1, kb[1], qr[1], x1); SUM4(y0, 12); PKB(y0, 12, pa1); KRD(3); if (dv) glds16(gv + 8192, lv + 8192); SBAR();
    QKM(x0, ka[2], qr[2], x0); SUM4(y1, 0); PKA(y1, 0);       SBAR();
    QKM(x1, kb[2], qr[2], x1); SUM4(y1, 4); PKB(y1, 4, pa2);  SBAR();
    QKM(x0, ka[3], qr[3], x0); SUM4(y1, 8); PKA(y1, 8);       SBAR();
    QKM(x1, kb[3], qr[3], x1); SUM4(y1, 12); PKB(y1, 12, pa3); VRD(0); VRD(1); SBAR();
    VRD(2); VRD(3); SBAR();
    if (near) {
        float tA[4], uA[4], tB[4], uB[4];
#define TLD(T, U, g) do { _Pragma("unroll") for (int j = 0; j < 4; ++j) { const int r_ = 4 * (g) + j, c_ = (r_ & 3) + 8 * (r_ >> 2); T[j] = *(const float*)(tabp + 4 * (59 - c_)); U[j] = *(const float*)(tabp + 4 * (59 - c_ - 32)); } } while (0)
#define TAD(T, U, g) do { _Pragma("unroll") for (int j = 0; j < 4; ++j) { const int r_ = 4 * (g) + j; asm volatile("v_add_f32 %0, %0, %1" : "+v"(x0[r_]) : "v"(T[j])); asm volatile("v_add_f32 %0, %0, %1" : "+v"(x1[r_]) : "v"(U[j])); } } while (0)
        TLD(tA, uA, 0); SBAR(); TLD(tB, uB, 1); SBAR();
        asm volatile("s_nop 15\n\ts_nop 7" : "+v"(x0), "+v"(x1));
        TAD(tA, uA, 0); SBAR(); TLD(tA, uA, 2); SBAR(); TAD(tB, uB, 1); SBAR(); TLD(tB, uB, 3); SBAR(); TAD(tA, uA, 2); SBAR(); TAD(tB, uB, 3);
#undef TLD
#undef TAD
    } else if (__builtin_expect(shift != 0.f, 0)) {
        asm volatile("s_nop 15\n\ts_nop 7" : "+v"(x0), "+v"(x1));
#pragma unroll
        for (int r = 0; r < 16; ++r) { asm volatile("v_sub_f32 %0, %0, %1" : "+v"(x0[r]) : "v"(shift)); asm volatile("v_sub_f32 %0, %0, %1" : "+v"(x1[r]) : "v"(shift)); }
    }
    SBAR();
#define GAPB(i, PA) do { if constexpr (!(VAR & 2)) o[(i) >> 2] = __builtin_amdgcn_mfma_f32_32x32x16_bf16(PA, VFR(i), o[(i) >> 2], 0, 0, 0); else asm volatile("" :: "v"(PA)); \
                         if constexpr (!(VAR & 1)) { x0[i] = __builtin_amdgcn_exp2f(x0[i]); x1[i] = __builtin_amdgcn_exp2f(x1[i]); } asm volatile("" : "+v"(x0), "+v"(x1)); \
                         if ((i) + 4 < 16) VRD((i) + 4); SBAR(); } while (0)
    GAPB(0, pa0); GAPB(1, pa1); GAPB(2, pa2); GAPB(3, pa3); GAPB(4, pa0); GAPB(5, pa1); GAPB(6, pa2); GAPB(7, pa3);
    GAPB(8, pa0); GAPB(9, pa1); GAPB(10, pa2); GAPB(11, pa3);
    if (wv == 3) asm volatile("s_waitcnt vmcnt(3)" ::: "memory"); else if (wv == 2) asm volatile("s_waitcnt vmcnt(2)" ::: "memory"); else asm volatile("s_waitcnt vmcnt(0)" ::: "memory");
    asm volatile("s_waitcnt lgkmcnt(0)\n\ts_barrier" ::: "memory");
    if (pre) { const char* a0_ = Kn + (((0 + hi) ^ sw) << 4); const char* a1_ = Kn + (((2 + hi) ^ sw) << 4);
        kp[0] = *reinterpret_cast<const bf16x8*>(a0_); kp[1] = *reinterpret_cast<const bf16x8*>(a0_ + 32 * 128); kp[2] = *reinterpret_cast<const bf16x8*>(a1_); kp[3] = *reinterpret_cast<const bf16x8*>(a1_ + 32 * 128); }
    SBAR();
    GAPB(12, pa0); GAPB(13, pa1); GAPB(14, pa2); GAPB(15, pa3);
    l_reg += ps;
#undef QKM
#undef KRD
#undef VRD
#undef VFR
#undef SUM4
#undef PKA
#undef PKB
#undef GAPB
}

struct BlockRef { const bf16_t* Q; const bf16_t* K; const bf16_t* V; int P0; int c; int m0; int h; };
struct Seam { bf16x8 qr[4];
#ifdef PROBE_WAITCYC
    unsigned long long wcyc;
#endif
};
struct Outs { const bf16_t* SG; bf16_t* BR; const float* subg; float lam; };
#define LASP __attribute__((address_space(3)))
#define WAIT_BAR() asm volatile("s_waitcnt vmcnt(0) lgkmcnt(0)\n\ts_barrier" ::: "memory")
#define VMW_N(n) asm volatile("s_waitcnt vmcnt(" #n ")" ::: "memory")
#define WAIT_BAR_N(n) asm volatile("s_waitcnt vmcnt(" #n ") lgkmcnt(0)\n\ts_barrier" ::: "memory")
#define DMA_K(Kp, j, slot) glds16((const char*)((Kp) + (size_t)(j) * 4096) + tid * 16, (unsigned)__builtin_amdgcn_readfirstlane(lds0 + L_K + (slot) * SHM_K + wid * 1024))
#define DMA_V(Vp, j, slot) do { glds16((const char*)((Vp) + (size_t)(j) * 8192) + tid * 16, (unsigned)__builtin_amdgcn_readfirstlane(lds0 + L_V + (slot) * SHM_V + wid * 1024)); \
                                glds16((const char*)((Vp) + (size_t)(j) * 8192 + 4096) + tid * 16, (unsigned)__builtin_amdgcn_readfirstlane(lds0 + L_V + (slot) * SHM_V + 8192 + wid * 1024)); } while (0)
__device__ __forceinline__ void dattn_issue(const BlockRef& b, char* lds, Seam& S) {
    int tid = threadIdx.x; asm volatile("" : "+v"(tid));
    const int wid = __builtin_amdgcn_readfirstlane(tid >> 6), lane = tid & 63, r32 = lane & 31, hi = lane >> 5;
    const unsigned lds0 = (unsigned)(uintptr_t)lds;
    DMA_K(b.K, 0, 0); DMA_V(b.V, 0, 0); DMA_K(b.K, 1, 1); DMA_V(b.V, 1, 1); DMA_K(b.K, 2, 2);
    int qoff = (wid * QBLK + r32) * AW + hi * 8; asm volatile("" : "+v"(qoff));
#pragma unroll
    for (int d0 = 0; d0 < 4; ++d0) S.qr[d0] = __builtin_nontemporal_load((const bf16x8*)(b.Q + qoff + d0 * 16));
}

#ifdef PROBE_WAITCYC
#define WC0() const unsigned long long wc0_ = __builtin_amdgcn_s_memtime()
#define WC1() S.wcyc += __builtin_amdgcn_s_memtime() - wc0_
#else
#define WC0() do { } while (0)
#define WC1() do { } while (0)
#endif
template <int VAR>
__device__ __forceinline__ void dattn_block(const BlockRef& cur, const BlockRef& nxt, bool has_next, char* lds, Seam& S, const Outs& OU) {
    const int tid = threadIdx.x, wid = __builtin_amdgcn_readfirstlane(tid >> 6), lane = tid & 63, r32 = lane & 31, hi = lane >> 5;
    const int NT = (cur.P0 + QB - 1) / KVBLK + 1;
    const int qlo = cur.P0 + wid * QBLK, qm = qlo + r32 - 4 * hi;
    const unsigned lds0 = (unsigned)(uintptr_t)lds;
    char* V_lds = lds + L_V; char* K_lds = lds + L_K;
    const char* tab = lds + L_TAB + cur.c * 2048;
    const float shift = *(const float*)(lds + L_MISC);
    float l_reg = 0; f32x16 o[4] = {};
    const lds_cptr vb3 = (lds_cptr)V_lds + v_rd_base(lane);
    const int sw = (r32 >> 1) & 7; const char* Kl = K_lds + r32 * 128;
    const bf16_t* Kh = cur.K; const bf16_t* Vh = cur.V;
#define KBASE(t) ((t) * KVBLK)
#define NEAR(t) (KBASE(t) > qlo - 176)
#define TABP(t) (tab + 4 * (qm - KBASE(t) + TAB_OFF - 59))
    f32x16 pA0, pA1, pB0, pB1; bf16x8 pa0, pa1, pa2, pa3;
    int s_prev = 0, s_cur = 0, s_next = 1;
#define ROT() do { s_prev = s_cur; s_cur = s_next; s_next = (s_next == NSLOT - 1) ? 0 : s_next + 1; } while (0)
    WAIT_BAR();
    SBAR(); qkt(0, pA0, pA1, K_lds, r32, hi, S.qr);
    startSM(pA0, pA1, NEAR(0), TABP(0), shift);
#pragma unroll
    for (int r = 0; r < 16; ++r) pA1[r] = __builtin_amdgcn_exp2f(pA1[r]);
    WAIT_BAR();
    ROT();
    bf16x8 kp[4];
    { const char* a0_ = Kl + s_cur * SHM_K + (((0 + hi) ^ sw) << 4); const char* a1_ = Kl + s_cur * SHM_K + (((2 + hi) ^ sw) << 4);
      kp[0] = *reinterpret_cast<const bf16x8*>(a0_); kp[1] = *reinterpret_cast<const bf16x8*>(a0_ + 32 * 128); kp[2] = *reinterpret_cast<const bf16x8*>(a1_); kp[3] = *reinterpret_cast<const bf16x8*>(a1_ + 32 * 128); }
#define STEP(PX0, PX1, PY0, PY1, t) do {                                                                                      \
        const char* gk_ = (const char*)(Kh + (size_t)((t) + 2) * 4096) + tid * 16; const char* gv_ = (const char*)(Vh + (size_t)((t) + 1) * 8192) + tid * 16;   \
        const unsigned lk_ = (unsigned)__builtin_amdgcn_readfirstlane(lds0 + L_K + s_prev * SHM_K + wid * 1024), lv_ = (unsigned)__builtin_amdgcn_readfirstlane(lds0 + L_V + s_next * SHM_V + wid * 1024);   \
        SBAR();                                                                                                               \
        step<VAR>(PX0, PX1, PY0, PY1, l_reg, o, S.qr, Kl + s_cur * SHM_K, sw, hi, vb3 + s_prev * SHM_V, NEAR(t), TABP(t), shift, (t) + 2 < NT, gk_, lk_, (t) + 1 < NT, gv_, lv_, kp, Kl + s_next * SHM_K, (t) + 1 < TL1, (t) + 2 < NT ? 3 : (t) + 1 < NT ? 2 : 0);         \
        ROT(); } while (0)
    const int TL1 = __builtin_amdgcn_readfirstlane((qlo + 31) / KVBLK + 1);
    int t = 1;
    for (; t + 1 < TL1; t += 2) { STEP(pB0, pB1, pA0, pA1, t); STEP(pA0, pA1, pB0, pB1, t + 1); }
    if (t < TL1) {
        STEP(pB0, pB1, pA0, pA1, t);
        pA0 = pB0; pA1 = pB1;
    }
#define STAGE_ISSUE(t) do { if ((t) + 2 < NT) DMA_K(Kh, (t) + 2, s_prev); if ((t) + 1 < NT) DMA_V(Vh, (t) + 1, s_next); } while (0)
#define STAGE_CLOSE(t) do { if ((t) + 2 < NT) { VMW_N(3); } else if ((t) + 1 < NT) { VMW_N(2); } else { VMW_N(0); } asm volatile("s_waitcnt lgkmcnt(0)\n\ts_barrier" ::: "memory"); ROT(); } while (0)
    if (TL1 < NT) STAGE_ISSUE(TL1);
    int tid_t = threadIdx.x; asm volatile("" : "+v"(tid_t));
    const int lane_t = tid_t & 63, r32_t = lane_t & 31, hi_t = lane_t >> 5;
    const int vb0_t = (int)(uintptr_t)V_lds + v_rd_base(lane_t) + s_prev * SHM_V;
    finishSM<false>(pA0, pA1, l_reg, pa0, pa1, pa2, pa3); SBAR();
    pv_tile(o, vb0_t, pa0, pa1, pa2, pa3);
    for (int ti = TL1; ti < NT; ++ti) { if (ti > TL1) STAGE_ISSUE(ti); STAGE_CLOSE(ti); }
#undef STAGE_ISSUE
#undef STAGE_CLOSE
    WAIT_BAR();
    if (has_next) dattn_issue(nxt, lds, S);
    { auto rr = __builtin_amdgcn_permlane32_swap(__float_as_uint(l_reg), __float_as_uint(l_reg), false, false); l_reg = __uint_as_float(rr[0]) + __uint_as_float(rr[1]); }
    float* li_l = (float*)(lds + L_WS) + wid * 64;
    if (hi_t == 0) li_l[r32_t] = l_reg; asm volatile("s_waitcnt lgkmcnt(0)" ::: "memory");
    float rli[16];
#pragma unroll
    for (int r = 0; r < 16; ++r) rli[r] = __builtin_amdgcn_rcpf(li_l[crow(r, hi_t)]);
    unsigned* o0w = (unsigned*)(lds + L_O0 + wid * 8192);
    if (cur.c == 0) {
#pragma unroll
        for (int d0 = 0; d0 < 4; ++d0)
#pragma unroll
            for (int r = 0; r < 16; r += 2) o0w[(d0 * 8 + (r >> 1)) * 64 + lane_t] = cvtpk(o[d0][r] * rli[r], o[d0][r + 1] * rli[r + 1]);
    } else {
        const float lam = OU.lam;
        const int ch = lane_t & 15;
        u32x4 gsg[8];
#pragma unroll
        for (int i = 0; i < 8; ++i) gsg[i] = __builtin_nontemporal_load((const u32x4*)(OU.SG + ((size_t)cur.m0 + wid * QBLK + i * 4 + (lane_t >> 4)) * AW + cur.h * 128 + ch * 8));
        const f32x4 sg0 = *(const f32x4*)(OU.subg + ch * 8), sg1 = *(const f32x4*)(OU.subg + ch * 8 + 4);
        unsigned short* stg = (unsigned short*)o0w;
#pragma unroll
        for (int d0 = 0; d0 < 4; ++d0)
#pragma unroll
            for (int r = 0; r < 16; r += 2) { const unsigned w = o0w[(d0 * 8 + (r >> 1)) * 64 + lane_t];
                o[d0][r] = __builtin_bit_cast(float, w << 16) - lam * (o[d0][r] * rli[r]);
                o[d0][r + 1] = __builtin_bit_cast(float, w & 0xffff0000u) - lam * (o[d0][r + 1] * rli[r + 1]); }
        asm volatile("s_waitcnt lgkmcnt(0)" ::: "memory");
#pragma unroll
        for (int r = 0; r < 16; ++r) { const int orow = crow(r, hi_t);
#pragma unroll
            for (int d0 = 0; d0 < 4; ++d0) stg[orow * 128 + d0 * 32 + r32_t] = (unsigned short)(cvtpk(o[d0][r], 0.f) & 0xffffu); }
        asm volatile("s_waitcnt lgkmcnt(0)" ::: "memory");
        constexpr float SC = 1.f - LAM_INIT;
#pragma unroll
        for (int i = 0; i < 8; ++i) { const int row = i * 4 + (lane_t >> 4);
            const u32x4 v = *(const u32x4*)(stg + row * 128 + ch * 8);
            float x0 = __builtin_bit_cast(float, v.x << 16), x1 = __builtin_bit_cast(float, v.x & 0xffff0000u), x2 = __builtin_bit_cast(float, v.y << 16), x3 = __builtin_bit_cast(float, v.y & 0xffff0000u);
            float x4 = __builtin_bit_cast(float, v.z << 16), x5 = __builtin_bit_cast(float, v.z & 0xffff0000u), x6 = __builtin_bit_cast(float, v.w << 16), x7 = __builtin_bit_cast(float, v.w & 0xffff0000u);
            float s = ((x0 * x0 + x1 * x1) + (x2 * x2 + x3 * x3)) + ((x4 * x4 + x5 * x5) + (x6 * x6 + x7 * x7));
            s += __shfl_xor(s, 1); s += __shfl_xor(s, 2); s += __shfl_xor(s, 4); s += __shfl_xor(s, 8);
            const float rn = rsqrtf(s * (1.f / 128.f) + EPS) * SC;
            const u32x4 g = gsg[i];
            u32x4 w;
            w.x = cvtpk(x0 * rn * __builtin_bit_cast(float, g.x << 16) * sg0[0], x1 * rn * __builtin_bit_cast(float, g.x & 0xffff0000u) * sg0[1]);
            w.y = cvtpk(x2 * rn * __builtin_bit_cast(float, g.y << 16) * sg0[2], x3 * rn * __builtin_bit_cast(float, g.y & 0xffff0000u) * sg0[3]);
            w.z = cvtpk(x4 * rn * __builtin_bit_cast(float, g.z << 16) * sg1[0], x5 * rn * __builtin_bit_cast(float, g.z & 0xffff0000u) * sg1[1]);
            w.w = cvtpk(x6 * rn * __builtin_bit_cast(float, g.w << 16) * sg1[2], x7 * rn * __builtin_bit_cast(float, g.w & 0xffff0000u) * sg1[3]);
            *(u32x4*)(OU.BR + ((size_t)cur.m0 + wid * QBLK + row) * 1024 + cur.h * 128 + ch * 8) = w; }
    }
    asm volatile("s_waitcnt lgkmcnt(0)" ::: "memory");
#undef KBASE
#undef NEAR
#undef TABP
#undef ROT
#undef STEP
}
#undef DMA_K
#undef DMA_V
#undef WAIT_BAR
#undef WAIT_BAR_N
#undef VMW_N
#undef LASP
#undef SBAR
}

constexpr int NWAVES = 8;
constexpr int RING_OFF = 0, RING_BYTES = 131072;
constexpr int LDS_BYTES = 163840;
constexpr int LDSCTL_OFF = LDS_BYTES - 1024, MISC_OFF = LDSCTL_OFF + 320;
static_assert(dattn::L_END <= LDSCTL_OFF && RING_BYTES <= LDSCTL_OFF, "LDS map");
constexpr int CW_ROWQ = 64;
constexpr int CW_BAR = 4096;
constexpr int CW_GROUP = 22528;
constexpr int CW_LOCAL = 28672;
constexpr size_t CTL_ZERO_BYTES = 128 * 1024;

struct Frame {
    LAS unsigned char* lds;
    volatile LAS unsigned* MISC;
    int tid, lane, wave, vcu, G;
};

__device__ __forceinline__ int nat_col(int p) {
    const int pn = p >> 8, t = p & 255;
    if (pn < 4) { const int bj = t >> 7, wc = (t >> 5) & 3, r = t & 31; return pn * 256 + 64 * wc + 32 * bj + r; }
    if (pn >= 8 && pn < 16) { const int bj = t >> 7, wc = (t >> 5) & 3, fq = (t >> 3) & 3, n = (t >> 2) & 1, i = t & 3;
        const int qty = bj == 0 ? (n == 0 ? 1 : 2) : (n == 0 ? 0 : 3);
        return 2048 + 512 * qty + 64 * (pn - 8) + 16 * wc + 4 * fq + i; }
    if (pn >= 16) { const int bj = t >> 7; return 4096 + 1024 * bj + 128 * (pn - 16) + (t & 127); }
    return p;
}
template <bool PERMUTE, bool SCALE>
__device__ __forceinline__ void p0_transpose_wg(Frame& F, const float* W, int K, int N, bf16* WT, const float* g, int item) {
    LAS float* T = (LAS float*)(F.lds + RING_OFF);
    const int nblk = N / 256, kb = item / nblk, nb = item % nblk, k0 = 64 * kb, n0 = 256 * nb;
    const int ncol = PERMUTE ? nat_col(n0 + 4 * F.lane) : n0 + 4 * F.lane;
    f32x4 v[8];
#pragma unroll
    for (int i = 0; i < 8; ++i) v[i] = __builtin_nontemporal_load((const GAS f32x4*)(W + (size_t)(k0 + 8 * F.wave + i) * N + ncol));
#pragma unroll
    for (int i = 0; i < 8; ++i) { const int kk = 8 * F.wave + i; f32x4 x = v[i]; if (SCALE) x = x * g[k0 + kk];
        T[kk * 257 + 4 * F.lane + 0] = x.x; T[kk * 257 + 4 * F.lane + 1] = x.y; T[kk * 257 + 4 * F.lane + 2] = x.z; T[kk * 257 + 4 * F.lane + 3] = x.w; }
    __syncthreads();
    const int c = F.lane & 7;
#pragma unroll
    for (int j = 0; j < 4; ++j) { const int n = 32 * F.wave + 8 * j + (F.lane >> 3); const LAS float* s = T + (8 * c) * 257 + n;
        v4u o; o.x = pk2(s[0 * 257], s[1 * 257]); o.y = pk2(s[2 * 257], s[3 * 257]); o.z = pk2(s[4 * 257], s[5 * 257]); o.w = pk2(s[6 * 257], s[7 * 257]);
        *(GAS v4u*)(WT + (size_t)(n0 + n) * K + k0 + 8 * c) = o; }
    __syncthreads();
}
__device__ __forceinline__ void rms_rows4_to_bf16(int lane, const float* x0, bf16* o0, size_t stride) {
    f32x4 v[4][4];
#pragma unroll
    for (int r = 0; r < 4; ++r) { const GAS f32x4* xr = (const GAS f32x4*)(x0 + r * stride) + lane;
#pragma unroll
        for (int j = 0; j < 4; ++j) v[r][j] = __builtin_nontemporal_load(&xr[64 * j]); }
#pragma unroll
    for (int r = 0; r < 4; ++r) { float s = 0.f;
#pragma unroll
        for (int j = 0; j < 4; ++j) s += (v[r][j].x * v[r][j].x + v[r][j].y * v[r][j].y) + (v[r][j].z * v[r][j].z + v[r][j].w * v[r][j].w);
        const float rs = rsqrtf(wave_sum(s) * (1.f / DM) + EPS);
        GAS unsigned long long* o8 = (GAS unsigned long long*)(o0 + r * stride) + lane;
#pragma unroll
        for (int j = 0; j < 4; ++j) o8[64 * j] = (unsigned long long)pk2(v[r][j].x * rs, v[r][j].y * rs) | ((unsigned long long)pk2(v[r][j].z * rs, v[r][j].w * rs) << 32); }
}

template <int NBLK>
__device__ __forceinline__ void p0_meta_task(Frame& F, const Ptrs& P, int task) {
    LAS float* xn = (LAS float*)(F.lds + RING_OFF);
    LAS float* part = (LAS float*)(F.lds + RING_OFF + 65536);
    for (int r = F.wave * 2; r < F.wave * 2 + 2; ++r) {
        float v[16]; float s = 0.f;
#pragma unroll
        for (int j = 0; j < 16; ++j) { v[j] = P.meta[(size_t)r * DM + j * 64 + F.lane]; s += v[j] * v[j]; }
        const float rs = rsqrtf(wave_sum(s) * (1.f / DM) + EPS);
#pragma unroll
        for (int j = 0; j < 16; ++j) xn[r * DM + j * 64 + F.lane] = v[j] * rs * P.norm_g[j * 64 + F.lane];
    }
    __syncthreads();
    const int type = task >> 3, g = task & 7;
    const int c0 = type == 0 ? 512 + 64 * g : type == 1 ? 1024 + 64 * g : 2048 + 512 + 64 * g;
    const int c1 = 2048 + 1024 + 64 * g;
    f32x4 acc[8];
#pragma unroll
    for (int i = 0; i < 8; ++i) acc[i] = (f32x4){0.f, 0.f, 0.f, 0.f};
    const int fr = F.lane & 15, fk = F.lane >> 4;
    for (int kc = 0; kc < 4; ++kc) {
        float bv[8][NBLK];
#pragma unroll
        for (int s = 0; s < 8; ++s) { const int k = F.wave * 128 + (kc * 8 + s) * 4 + fk;
#pragma unroll
            for (int blk = 0; blk < NBLK; ++blk) bv[s][blk] = P.w_in[(size_t)k * INC + (blk < 4 ? c0 + 16 * blk : c1 + 16 * (blk - 4)) + fr]; }
        asm volatile("" ::: "memory");
#pragma unroll
        for (int s = 0; s < 8; ++s) { const float a = xn[fr * DM + F.wave * 128 + (kc * 8 + s) * 4 + fk];
#pragma unroll
            for (int blk = 0; blk < NBLK; ++blk) acc[blk] = __builtin_amdgcn_mfma_f32_16x16x4f32(a, bv[s][blk], acc[blk], 0, 0, 0); }
    }
#pragma unroll
    for (int blk = 0; blk < 8; ++blk)
#pragma unroll
        for (int reg = 0; reg < 4; ++reg) part[(F.wave * 16 + 4 * fk + reg) * 128 + 16 * blk + fr] = acc[blk][reg];
    __syncthreads();
    bf16* KI = (bf16*)(P.ws + WS_K); bf16* VI = (bf16*)(P.ws + WS_V); bf16* U = (bf16*)(P.ws + WS_U);
    for (int r = F.wave * 2; r < F.wave * 2 + 2; ++r) {
        float v0 = 0.f, v1 = 0.f;
#pragma unroll
        for (int w = 0; w < 8; ++w) { v0 += part[(w * 16 + r) * 128 + F.lane]; v1 += part[(w * 16 + r) * 128 + 64 + F.lane]; }
        if (type == 0) {
            const float ss = wave_sum(v0 * v0);
            const unsigned short o = (unsigned short)f2bf(v0 * rsqrtf(ss * (1.f / 64.f) + EPS) * P.k_norm_g[F.lane]);
            for (int b = 0; b < BATCH; ++b) KI[kimg_off(b, g >> 1, g & 1, r, F.lane)] = o;
        } else if (type == 1) {
            const unsigned short o = (unsigned short)f2bf(v0);
            for (int b = 0; b < BATCH; ++b) VI[vimg_off(b, g >> 1, r, (g & 1) * 64 + F.lane)] = o;
        } else {
            const unsigned short o = (unsigned short)f2bf(v0 * v1);
            for (int b = 0; b < BATCH; ++b) U[((size_t)b * LTOK + r) * CW + 64 * g + F.lane] = o;
        }
    }
    __syncthreads();
}

#ifdef PROBE_AMP
#define STAMP(k) do { if (blockIdx.x == 0 && F.tid == 0) { const unsigned long long t_ = rt(); F.MISC[16 + 2 * (k)] = (unsigned)t_; F.MISC[17 + 2 * (k)] = (unsigned)(t_ >> 32); } } while (0)
#else
#define STAMP(k) do { } while (0)
#endif
__device__ __forceinline__ void p0_prologue(Frame& F, const Ptrs& P) {
    if (F.vcu < 16) p0_meta_task<4>(F, P, F.vcu); else if (F.vcu < 24) p0_meta_task<8>(F, P, F.vcu);
    STAMP(6);
    const int gw = F.vcu * NWAVES + F.wave, NGW = F.G * NWAVES;
    bf16* WIN = (bf16*)(P.ws + WS_WIN); bf16* WBR = (bf16*)(P.ws + WS_WBR); bf16* WOUT = (bf16*)(P.ws + WS_WOUT); bf16* XB = (bf16*)(P.ws + WS_XB);
    constexpr int I_IN = (DM / 64) * (INC / 256), I_SQ = (DM / 64) * (DM / 256);
    for (int it = F.vcu; it < I_IN + 2 * I_SQ; it += F.G) {
        int r = it;
        if (r < I_IN) { p0_transpose_wg<true, true>(F, P.w_in, DM, INC, WIN, P.norm_g, r); continue; } r -= I_IN;
        if (r < I_SQ) { p0_transpose_wg<false, false>(F, P.w_branch, DM, DM, WBR, nullptr, r); continue; } r -= I_SQ;
        p0_transpose_wg<false, false>(F, P.w_out, DM, DM, WOUT, nullptr, r);
    }
    STAMP(7);
    for (;;) {
        if (F.tid == 0) F.MISC[12] = __hip_atomic_fetch_add((unsigned*)(P.ws + WS_CTL) + CW_ROWQ, 1u, __ATOMIC_RELAXED, __HIP_MEMORY_SCOPE_AGENT);
        __syncthreads();
        const unsigned c = F.MISC[12];
        __syncthreads();
        if (c >= (unsigned)(MROWS / 32)) break;
        const size_t m0 = (size_t)c * 32 + F.wave * 4;
        rms_rows4_to_bf16(F.lane, P.x + m0 * DM, XB + m0 * DM, (size_t)DM);
    }
    STAMP(8);
    { GAS v4u* KI = (GAS v4u*)(P.ws + WS_K); GAS v4u* VI = (GAS v4u*)(P.ws + WS_V); const v4u z = {0u, 0u, 0u, 0u};
      const int gt = F.vcu * 512 + F.tid, NT_ = F.G * 512;
      for (int i = gt; i < 64 * 512; i += NT_) KI[((size_t)(i >> 9) * NKT + 64) * 512 + (i & 511)] = z;
      for (int i = gt; i < 32 * 1024; i += NT_) VI[((size_t)(i >> 10) * NKT + 64) * 1024 + (i & 1023)] = z; }
}

__device__ __forceinline__ void conv_fixup(Frame& F, const Ptrs& P, int first, int count, int gw, int NGW) {
    const bf16* U = (const bf16*)(P.ws + WS_U); const bf16* GB = (const bf16*)(P.ws + WS_GB); bf16* BR = (bf16*)(P.ws + WS_BR);
    const int ch0 = F.lane * 8;
    const f32x4 w0a = *(const f32x4*)(P.conv_w + ch0), w0b = *(const f32x4*)(P.conv_w + ch0 + 4);
    const f32x4 w1a = *(const f32x4*)(P.conv_w + CW + ch0), w1b = *(const f32x4*)(P.conv_w + CW + ch0 + 4);
    const f32x4 w2a = *(const f32x4*)(P.conv_w + 2 * CW + ch0), w2b = *(const f32x4*)(P.conv_w + 2 * CW + ch0 + 4);
    for (int it = first + gw; it < first + count; it += NGW) {
        const int m = (it >> 1) * 64 + (it & 1), b = m / SEQ, s = m % SEQ; const size_t ur = (size_t)b * LTOK + s + NMETA;
        const v4u um2 = *(const GAS v4u*)(U + (ur - 2) * CW + ch0), um1 = *(const GAS v4u*)(U + (ur - 1) * CW + ch0), u0 = *(const GAS v4u*)(U + ur * CW + ch0), gb = *(const GAS v4u*)(GB + (size_t)m * CW + ch0);
        v4u o;
#define CONV2(W, k0_, wa, wb, wc) { const float ylo = wa[k0_] * bflo_(um2.W) + wb[k0_] * bflo_(um1.W) + wc[k0_] * bflo_(u0.W); \
                                    const float yhi = wa[k0_ + 1] * bfhi_(um2.W) + wb[k0_ + 1] * bfhi_(um1.W) + wc[k0_ + 1] * bfhi_(u0.W); \
                                    o.W = pk2(bflo_(gb.W) * ylo, bfhi_(gb.W) * yhi); }
        CONV2(x, 0, w0a, w1a, w2a) CONV2(y, 2, w0a, w1a, w2a) CONV2(z, 0, w0b, w1b, w2b) CONV2(w, 2, w0b, w1b, w2b)
#undef CONV2
        *(GAS v4u*)(BR + (size_t)m * 1024 + 512 + ch0) = o;
    }
}

__device__ __forceinline__ dattn::BlockRef mk_block(const Ptrs& P, int vcu, int i) {
    const int bh = vcu >> 3, j = vcu & 7, b = bh >> 2, h = bh & 3, qb = (i < 2) ? j : 15 - j, c = i & 1; dattn::BlockRef r;
    r.Q = (const bf16*)(P.ws + WS_Q) + ((size_t)b * SEQ + (size_t)qb * 256) * AW + (h * 2 + c) * 64;
    r.K = (const bf16*)(P.ws + WS_K) + (size_t)((b * NH + h) * 2 + c) * NKT * 4096;
    r.V = (const bf16*)(P.ws + WS_V) + (size_t)(b * NH + h) * NKT * 8192;
    r.P0 = NMETA + qb * 256; r.c = c; r.m0 = b * SEQ + qb * 256; r.h = h; return r;
}

struct Args { Ptrs P; int ph_lo, ph_hi, li, pad; };
__global__ void __launch_bounds__(NWAVES * 64, 2) mega_fwd(Args args) {
    extern __shared__ __attribute__((aligned(16))) unsigned char lds[];
    const Ptrs& P = args.P;
    Frame F;
    F.lds = (LAS unsigned char*)lds;
    F.MISC = (volatile LAS unsigned*)(F.lds + MISC_OFF);
    F.tid = threadIdx.x; F.lane = F.tid & 63; F.wave = __builtin_amdgcn_readfirstlane(F.tid >> 6);
    F.G = gridDim.x; { const int bx = blockIdx.x; F.vcu = (F.G % 8 == 0) ? (bx % 8) * (F.G / 8) + bx / 8 : bx; }
    gu32* ctl = (gu32*)(P.ws + WS_CTL);
    for (int u = F.tid; u < (LDS_BYTES - LDSCTL_OFF) / 4; u += NWAVES * 64) ((LAS unsigned*)(F.lds + LDSCTL_OFF))[u] = 0u;
    __syncthreads();
    XcdBarrier bar = xcd_barrier_post((unsigned*)(ctl + CW_BAR) + args.li * XCD_BAR_WORDS, F.MISC + 8);
    const int lo = args.ph_lo, hi = args.ph_hi;
#ifndef PH_COMPILED
#define PH_COMPILED 0x1F
#endif
#define IN(k) (((PH_COMPILED >> (k)) & 1) && lo <= (k) && (k) < hi)
#define BOTH(k) (IN(k) && IN((k) + 1))
    STAMP(0);
    if (IN(0)) { p0_prologue(F, P); if (BOTH(0)) xcd_barrier(bar); }
    STAMP(1);
    if (IN(1)) {
        pg8::Gemm g{(const bf16*)(P.ws + WS_XB), (const bf16*)(P.ws + WS_WIN), MROWS, INC, DM}; const bool lv = (F.MISC[11] == 1u) && F.G == 256 && IN(0);
        pg8::StaticOrder S; S.init(MROWS, INC, F.G, lv ? (int)F.MISC[10] * 8 + (int)bar.x : (int)blockIdx.x, 2);
        pg8::EpiProj E{(bf16*)(P.ws + WS_Q), (bf16*)(P.ws + WS_K), (bf16*)(P.ws + WS_V), (bf16*)(P.ws + WS_SG), (bf16*)(P.ws + WS_U), (bf16*)(P.ws + WS_GB), (bf16*)(P.ws + WS_GATE), (bf16*)(P.ws + WS_GATE + 64 * MiB), (bf16*)(P.ws + WS_BR), P.q_norm_g, P.k_norm_g, P.conv_w};
        pg8::gemm_phase<pg8::EpiProj, pg8::StaticOrder, true, true>(F.lds + RING_OFF, g, S, E);
        if (BOTH(1)) { if (lv) xcd_local_barrier(bar.bar, (unsigned*)ctl + CW_LOCAL + args.li * 1024, bar.x); else xcd_barrier(bar); }
    }
    STAMP(2);
    if (IN(2)) {
        const bool lv = (F.MISC[11] == 1u) && F.G == 256 && IN(0) && IN(1);
        const int vcu2 = lv ? (int)bar.x * 32 + (int)F.MISC[10] : F.vcu;
        dattn::Seam S; dattn::BlockRef cur = mk_block(P, vcu2, 0);
        if (F.G == 256) dattn::dattn_issue(cur, (char*)lds + RING_OFF, S);
        const bool gv = lv && args.li == 0;
        if (gv) { const int j_ = (int)F.MISC[10] & 7, gw_ = ((int)F.MISC[10] >> 3) * NWAVES + F.wave;
                  conv_fixup(F, P, 8 * (16 * (int)bar.x + j_), 8, gw_, 4 * NWAVES); conv_fixup(F, P, 8 * (16 * (int)bar.x + 15 - j_), 8, gw_, 4 * NWAVES); }
        else if (lv) conv_fixup(F, P, 128 * (int)bar.x, 128, (int)F.MISC[10] * NWAVES + F.wave, 32 * NWAVES); else conv_fixup(F, P, 0, MROWS / 32, F.vcu * NWAVES + F.wave, F.G * NWAVES);
        STAMP(9);
#ifdef PROBE_CLK
        if (blockIdx.x == 0 && F.tid == 0) { const unsigned long long c_ = __builtin_amdgcn_s_memtime(); F.MISC[60] = (unsigned)c_; F.MISC[61] = (unsigned)(c_ >> 32); }
#endif
        if (F.G == 256) {
            char* al = (char*)lds + RING_OFF;
            float gq = fabsf(P.q_norm_g[F.lane]), gk = fabsf(P.k_norm_g[F.lane]), gb = fmaxf(fmaxf(fabsf(P.rel_bias[F.lane]), fabsf(P.rel_bias[64 + F.lane])), fmaxf(fabsf(P.rel_bias[128 + F.lane]), fabsf(P.rel_bias[192 + F.lane])));
            gq = wave_max(gq); gk = wave_max(gk); gb = wave_max(gb);
            const float bound = 64.f * C2 * gq * gk + 2.f * LOG2E * gb, shift = bound > 100.f ? bound : 0.f;
            dattn::Outs OU{(const bf16*)(P.ws + WS_SG), (bf16*)(P.ws + WS_BR), P.subln_g, compute_lam(P, F.lane)};
#if defined(PROBE_WAITCYC) || defined(PROBE_SEG) || defined(PROBE_BSEG)
            S.wcyc = 0ull;
#endif
            {
                if (F.tid == 0) *(float*)(al + dattn::L_MISC) = shift;
                for (int e = F.tid; e < 1024; e += NWAVES * 64) { const int c = e >> 9, jj = e & 511, d = jj - dattn::TAB_OFF;
                    const int dd = d > 113 ? 113 : d;
                    ((float*)(al + dattn::L_TAB))[e] = d < 0 ? -__builtin_inff() : (P.rel_bias[(t5_bucket(dd) * NH + cur.h) * 2 + c] - P.rel_bias[(31 * NH + cur.h) * 2 + c]) * LOG2E - shift; }
                __syncthreads();
            }
            _Pragma("unroll 1") for (int i = 0; i < 4; ++i) {
                const dattn::BlockRef nxt = mk_block(P, vcu2, i < 3 ? i + 1 : 3); dattn::dattn_block<0>(cur, nxt, i < 3, al, S, OU); cur = nxt; }
            __syncthreads();
#if defined(PROBE_WAITCYC) || defined(PROBE_SEG) || defined(PROBE_BSEG)
            if (blockIdx.x == 0 && F.tid == 0) { F.MISC[58] = (unsigned)S.wcyc; F.MISC[59] = (unsigned)(S.wcyc >> 32); }
#endif
        }
        if (BOTH(2)) { if (gv) xcd_local_barrier(bar.bar, (unsigned*)ctl + CW_GROUP, bar.x * 8u + (F.MISC[10] & 7u), 4u);
                       else if (lv) xcd_local_barrier(bar.bar, (unsigned*)ctl + CW_LOCAL + args.li * 1024, bar.x); else xcd_barrier(bar); }
    }
#ifdef PROBE_CLK
    if (blockIdx.x == 0 && F.tid == 0) { const unsigned long long c_ = __builtin_amdgcn_s_memtime(); F.MISC[62] = (unsigned)c_; F.MISC[63] = (unsigned)(c_ >> 32); }
#endif
    STAMP(3);
    if (IN(3)) {
        const bool lv = (F.MISC[11] == 1u) && F.G == 256 && IN(0) && IN(1) && IN(2);
        pg8::Gemm g{(const bf16*)(P.ws + WS_BR), (const bf16*)(P.ws + WS_WBR), MROWS, DM, DM}; pg8::XcdOrder S; S.so.init(MROWS, DM, F.G, (int)blockIdx.x); S.local = lv ? (args.li == 0 ? 2 : 1) : 0; S.xcc = (int)bar.x; S.rank = (int)F.MISC[10];
        pg8::EpiMerge E{(const bf16*)(P.ws + WS_GATE), (const bf16*)(P.ws + WS_GATE + 64 * MiB), (bf16*)(P.ws + WS_MERGED)
#ifdef PROBE_P3CYC
            , (unsigned long long*)(P.ws + WS_CTL + 1024)
#endif
        };
        pg8::gemm_phase<pg8::EpiMerge, pg8::XcdOrder, true, true>(F.lds + RING_OFF, g, S, E);
        if (BOTH(3)) { if (lv && args.li == 0) xcd_local_barrier(bar.bar, (unsigned*)ctl + CW_GROUP, bar.x * 8u + (F.MISC[10] & 7u), 4u);
                       else if (lv) xcd_local_barrier(bar.bar, (unsigned*)ctl + CW_LOCAL + args.li * 1024, bar.x); else xcd_barrier(bar); }
    }
    STAMP(4);
    if (IN(4)) {
        const bool lv = (F.MISC[11] == 1u) && F.G == 256 && IN(0) && IN(1) && IN(2) && IN(3);
        pg8::Gemm g{(const bf16*)(P.ws + WS_MERGED), (const bf16*)(P.ws + WS_WOUT), MROWS, DM, DM}; pg8::XcdOrder S; S.so.init(MROWS, DM, F.G, (int)blockIdx.x); S.local = lv ? (args.li == 0 ? 2 : 1) : 0; S.xcc = (int)bar.x; S.rank = (int)F.MISC[10];
        pg8::EpiOut E{P.x, P.out};
        pg8::gemm_phase<pg8::EpiOut, pg8::XcdOrder, true, true>(F.lds + RING_OFF, g, S, E);
    }
    STAMP(5);
#ifdef PROBE_AMP
    if (blockIdx.x == 0 && F.tid == 0) { LDS_WAIT();
        const unsigned long long ta = ((unsigned long long)F.MISC[17 + 2 * PROBE_AMP] << 32) | F.MISC[16 + 2 * PROBE_AMP], tb = ((unsigned long long)F.MISC[17 + 2 * PROBE_AMP_B] << 32) | F.MISC[16 + 2 * PROBE_AMP_B];
#if defined(PROBE_P3CYC)
        const unsigned long long wc_ = *(volatile unsigned long long*)(P.ws + WS_CTL + 1024);
        const unsigned long long tc0_ = __builtin_amdgcn_s_memtime(); while (__builtin_amdgcn_s_memtime() - tc0_ < 9ull * wc_) __builtin_amdgcn_s_sleep(16);
        const unsigned long long target = rt();
#elif defined(PROBE_WAITCYC) || defined(PROBE_SEG) || defined(PROBE_BSEG)
        const unsigned long long wc_ = ((unsigned long long)F.MISC[59] << 32) | F.MISC[58];
        const unsigned long long tc0_ = __builtin_amdgcn_s_memtime(); while (__builtin_amdgcn_s_memtime() - tc0_ < 9ull * wc_) __builtin_amdgcn_s_sleep(16);
        const unsigned long long target = rt();
#elif defined(PROBE_CLK)
        const unsigned long long c0_ = ((unsigned long long)F.MISC[61] << 32) | F.MISC[60], c1_ = ((unsigned long long)F.MISC[63] << 32) | F.MISC[62];
        const unsigned long long target = rt() + (c1_ - c0_) * 1000ull / (tb - ta);
#else
        const unsigned long long target = rt() + 9ull * (tb - ta);
#endif
        while (rt() < target) __builtin_amdgcn_s_sleep(16); }
#endif
#undef IN
#undef BOTH
}

extern "C" void kernel_launch(void* const* d_in, const int* in_sizes, int n_in, void* d_out, int out_size, void* d_ws, size_t ws_size, hipStream_t stream) {
    static int grid = 0;
    if (grid == 0) {
        if (n_in != 15 || out_size != MROWS * DM || ws_size < WS_END) { fprintf(stderr, "kernel_launch: unexpected shapes n_in %d out %d ws %zu\n", n_in, out_size, ws_size); grid = -1; return; }
        int dev = 0, cus = 0;
        if (hipGetDevice(&dev) != hipSuccess || hipDeviceGetAttribute(&cus, hipDeviceAttributeMultiprocessorCount, dev) != hipSuccess) { grid = -1; return; }
        if (hipFuncSetAttribute((const void*)mega_fwd, hipFuncAttributeMaxDynamicSharedMemorySize, LDS_BYTES) != hipSuccess) { fprintf(stderr, "kernel_launch: hipFuncSetAttribute failed\n"); grid = -1; return; }
        if (cus < 256) { fprintf(stderr, "kernel_launch: needs 256 CUs, device has %d\n", cus); grid = -1; return; }
        grid = 256;
    }
    if (grid < 0) return;
    Ptrs P{};
    P.x = (const float*)d_in[0]; P.meta = (const float*)d_in[1]; P.rel_bias = (const float*)d_in[2]; P.norm_g = (const float*)d_in[3]; P.w_in = (const float*)d_in[4];
    P.q_norm_g = (const float*)d_in[5]; P.k_norm_g = (const float*)d_in[6]; P.lq1 = (const float*)d_in[7]; P.lk1 = (const float*)d_in[8]; P.lq2 = (const float*)d_in[9];
    P.lk2 = (const float*)d_in[10]; P.subln_g = (const float*)d_in[11]; P.conv_w = (const float*)d_in[12]; P.w_branch = (const float*)d_in[13]; P.w_out = (const float*)d_in[14];
    P.out = (float*)d_out; P.ws = (unsigned char*)d_ws;
    if (hipMemsetAsync((char*)d_ws + WS_CTL, 0, CTL_ZERO_BYTES, stream) != hipSuccess) { fprintf(stderr, "kernel_launch: memset failed\n"); return; }
#ifdef PROBE_MEMSET2
    hipMemsetAsync((char*)d_ws + WS_END - (1 << 20), 0, CTL_ZERO_BYTES, stream);
#endif
    int li = 0;
#ifdef PROBE_TWICE
    const int seq[2][2] = {{0, 5}, {0, 5}}; const int nseq = 2;
#elif defined(PROBE_REPEAT)
    const int seq[2][2] = {{0, PROBE_REPEAT + 1}, {PROBE_REPEAT, 5}}; const int nseq = 2;
#else
    const int seq[1][2] = {{0, 5}}; const int nseq = 1;
#endif
    for (int s = 0; s < nseq; ++s) {
        Args a{}; a.P = P; a.ph_lo = seq[s][0]; a.ph_hi = seq[s][1]; a.li = li++; a.pad = 0;
        hipLaunchKernelGGL(mega_fwd, dim3(grid), dim3(NWAVES * 64), LDS_BYTES, stream, a);
    }
}
```
